# Optimizing an MI355X kernel written in HIP

```python
import jax, jax.numpy as jnp
from jax import lax
import numpy as np

D_MODEL = 1024
BATCH = 8
SEQ = 2048
DEPTH = 4

GRID_W = 64
CTX_LEN = 256
N_MIXERS = 3
HEAD_DIM = 64
N_Q_HEADS = D_MODEL // HEAD_DIM
N_KV_HEADS = N_Q_HEADS // 4
Q_BLOCK = 128
ROPE_THETA = 10000.0
RET_HEAD_DIM = 256
RET_HEADS = D_MODEL // RET_HEAD_DIM
RET_V_DIM = 2 * RET_HEAD_DIM
RET_CHUNK = 128
RET_DECAY_BASE = 5.0
D_FF = ((8 * D_MODEL // 3 + 127) // 128) * 128
NORM_EPS = 1e-6
N_CONV_LAYERS = len(range(0, DEPTH, N_MIXERS))
N_ATTN_LAYERS = len(range(1, DEPTH, N_MIXERS))
N_RET_LAYERS = len(range(2, DEPTH, N_MIXERS))

kernel_name = "hybrid_shortconv_gqa_retention_dit"


def rmsnorm(x, g=None):
    xf = x.astype(jnp.float32)
    y = xf * lax.rsqrt(jnp.mean(xf * xf, axis=-1, keepdims=True) + NORM_EPS)
    if g is not None:
        y = y * g.astype(jnp.float32)
    return y.astype(x.dtype)


def modulate(x, g, shift, scale):
    return rmsnorm(x, g) * (1 + scale) + shift


def dwconv3(x, w):
    xp = jnp.pad(x, ((0, 0), (1, 1), (0, 0)))
    return xp[:, :-2] * w[0] + xp[:, 1:-1] * w[1] + xp[:, 2:] * w[2]


def axial_angles(rows, cols, head_dim):
    quarter = head_dim // 4
    inv = ROPE_THETA ** (-jnp.arange(quarter, dtype=jnp.float32) / quarter)
    ang = jnp.stack([rows[:, None] * inv, cols[:, None] * inv], axis=1)
    return jnp.cos(ang), jnp.sin(ang)


def apply_axial_rope(x, cos, sin):
    B, L, H, d = x.shape
    xr = x.reshape(B, L, H, 2, 2, d // 4)
    c = cos[None, :, None].astype(x.dtype)
    s = sin[None, :, None].astype(x.dtype)
    x1 = xr[..., 0, :]
    x2 = xr[..., 1, :]
    out = jnp.stack([x1 * c - x2 * s, x1 * s + x2 * c], axis=-2)
    return out.reshape(B, L, H, d)


def short_conv_mixer(h, w_in, conv_k, w_out):
    b_gate, c_gate, v = jnp.split(h @ w_in, 3, axis=-1)
    return (b_gate * dwconv3(c_gate * v, conv_k)) @ w_out


def gqa_project(t, w_qkv, q_g, k_g, with_q):
    B, L, _ = t.shape
    nq = N_Q_HEADS * HEAD_DIM
    nkv = N_KV_HEADS * HEAD_DIM
    if with_q:
        q, k, v = jnp.split(t @ w_qkv, [nq, nq + nkv], axis=-1)
        q = rmsnorm(q.reshape(B, L, N_Q_HEADS, HEAD_DIM), q_g)
    else:
        k, v = jnp.split(t @ w_qkv[:, nq:], 2, axis=-1)
        q = None
    k = rmsnorm(k.reshape(B, L, N_KV_HEADS, HEAD_DIM), k_g)
    v = v.reshape(B, L, N_KV_HEADS, HEAD_DIM)
    return q, k, v


def sdpa_grouped(q, k, v):
    s = jnp.einsum('bqhgd,bkhd->bhgqk', q, k).astype(jnp.float32) * (q.shape[-1] ** -0.5)
    p = jax.nn.softmax(s, axis=-1).astype(v.dtype)
    return jnp.einsum('bhgqk,bkhd->bqhgd', p, v)


def gqa_mixer(h, hc, w_qkv, q_g, k_g, w_out, cos, sin, ctx_out):
    B, S, _ = h.shape
    G = N_Q_HEADS // N_KV_HEADS
    q, k, v = gqa_project(h, w_qkv, q_g, k_g, True)
    q = apply_axial_rope(q, cos, sin)
    k = apply_axial_rope(k, cos, sin)
    qc, kc, vc = gqa_project(hc, w_qkv, q_g, k_g, ctx_out)
    keys = jnp.concatenate([k, kc], axis=1)
    vals = jnp.concatenate([v, vc], axis=1)
    qb = q.reshape(B, S // Q_BLOCK, Q_BLOCK, N_KV_HEADS, G, HEAD_DIM).swapaxes(0, 1)
    ob = lax.map(lambda q_blk: sdpa_grouped(q_blk, keys, vals), qb)
    y = ob.swapaxes(0, 1).reshape(B, S, D_MODEL) @ w_out
    yc = None
    if ctx_out:
        Lc = hc.shape[1]
        oc = sdpa_grouped(qc.reshape(B, Lc, N_KV_HEADS, G, HEAD_DIM), kc, vc)
        yc = oc.reshape(B, Lc, D_MODEL) @ w_out
    return y, yc


def ret_project(t, w_in, with_qg):
    B, L, _ = t.shape
    nqk = RET_HEADS * RET_HEAD_DIM
    nv = RET_HEADS * RET_V_DIM
    if with_qg:
        q, k, v, g = jnp.split(t @ w_in, [nqk, 2 * nqk, 2 * nqk + nv], axis=-1)
        q = q.reshape(B, L, RET_HEADS, RET_HEAD_DIM)
    else:
        k, v = jnp.split(t @ w_in[:, nqk:2 * nqk + nv], [nqk], axis=-1)
        q = g = None
    k = k.reshape(B, L, RET_HEADS, RET_HEAD_DIM) * (RET_HEAD_DIM ** -0.5)
    v = v.reshape(B, L, RET_HEADS, RET_V_DIM)
    return q, k, v, g


def retention_scan(q, k, v, log_g, state0, strict):
    B, L, H, dk = q.shape
    dv = v.shape[-1]
    C = RET_CHUNK
    n = L // C
    pos = jnp.arange(C, dtype=jnp.float32)
    diff = pos[:, None] - pos[None, :]
    mask = diff > 0 if strict else diff >= 0
    intra_decay = jnp.where(mask[None], jnp.exp(jnp.where(mask, diff, 0.0)[None] * log_g[:, None, None]), 0.0).astype(q.dtype)
    q_decay = jnp.exp((pos + 1)[:, None] * log_g[None]).astype(q.dtype)
    k_decay = jnp.exp((C - 1 - pos)[:, None] * log_g[None]).astype(q.dtype)
    chunk_decay = jnp.exp(C * log_g).astype(q.dtype)[None, :, None, None]
    qc = q.reshape(B, n, C, H, dk)
    kc = k.reshape(B, n, C, H, dk)
    vc = v.reshape(B, n, C, H, dv)
    scores = jnp.einsum('bnihd,bnjhd->bnhij', qc, kc) * intra_decay
    intra = jnp.einsum('bnhij,bnjhe->bnihe', scores, vc)
    xs = ((qc * q_decay[:, :, None]).swapaxes(0, 1),
          (kc * k_decay[:, :, None]).swapaxes(0, 1),
          vc.swapaxes(0, 1))

    def step(state, inp):
        qd, kd, vv = inp
        inter = jnp.einsum('bihd,bhde->bihe', qd, state)
        state = chunk_decay * state + jnp.einsum('bjhd,bjhe->bhde', kd, vv)
        return state, inter

    state, inter = lax.scan(step, state0, xs)
    out = intra + inter.swapaxes(0, 1)
    return out.reshape(B, L, H, dv), state


def retention_final_state(k, v, log_g):
    L = k.shape[1]
    w = jnp.exp((L - 1 - jnp.arange(L, dtype=jnp.float32))[:, None] * log_g[None]).astype(k.dtype)
    return jnp.einsum('blhd,blhe->bhde', k * w[:, :, None], v)


def ret_output(y, g, w_out):
    B, L = y.shape[:2]
    yn = rmsnorm(y).reshape(B, L, RET_HEADS * RET_V_DIM)
    return (jax.nn.silu(g) * yn) @ w_out


def retention_mixer(h, hc, w_in, decay_exp, w_out, cos, sin, ctx_out):
    log_g = jnp.log1p(-jnp.exp2(-decay_exp.astype(jnp.float32)))
    flip = lambda t: jnp.flip(t, axis=1)
    q, k, v, g = ret_project(h, w_in, True)
    q = apply_axial_rope(q, cos, sin)
    k = apply_axial_rope(k, cos, sin)
    qc, kc, vc, gc = ret_project(hc, w_in, ctx_out)
    yc = None
    if ctx_out:
        B = hc.shape[0]
        zero = jnp.zeros((B, RET_HEADS, RET_HEAD_DIM, RET_V_DIM), vc.dtype)
        yc_f, st_f = retention_scan(qc, kc, vc, log_g[0], zero, False)
        yc_b, st_b = retention_scan(flip(qc), flip(kc), flip(vc), log_g[1], zero, True)
        yc = ret_output(yc_f + flip(yc_b), gc, w_out)
    else:
        st_f = retention_final_state(kc, vc, log_g[0])
        st_b = retention_final_state(flip(kc), flip(vc), log_g[1])
    y_f, _ = retention_scan(q, k, v, log_g[0], st_f, False)
    y_b, _ = retention_scan(flip(q), flip(k), flip(v), log_g[1], st_b, True)
    return ret_output(y_f + flip(y_b), g, w_out), yc


def conv_ffn(h, w_up, conv_k, conv_b, w_down):
    u = dwconv3(h @ w_up, conv_k) + conv_b
    val, gate = jnp.split(u, 2, axis=-1)
    return (jax.nn.silu(gate) * val) @ w_down


def setup_inputs(seed: int = 0) -> dict:
    key = jax.random.key(seed)
    ks = iter(jax.random.split(key, 32))
    f32 = jnp.float32

    def normal(shape):
        return jax.random.normal(next(ks), shape, f32)

    def dense(shape, fan_in, gain=1.0):
        return normal(shape) * (gain * fan_in ** -0.5)

    qkv_w = (N_Q_HEADS + 2 * N_KV_HEADS) * HEAD_DIM
    ret_in_w = 2 * RET_HEADS * RET_HEAD_DIM + 2 * RET_HEADS * RET_V_DIM
    ret_v_w = RET_HEADS * RET_V_DIM
    return {
        "x": normal((BATCH, SEQ, D_MODEL)),
        "c": normal((BATCH, D_MODEL)),
        "ctx": normal((BATCH, CTX_LEN, D_MODEL)),
        "c_ctx": normal((D_MODEL,)),
        "ada_w": dense((DEPTH, D_MODEL, 6 * D_MODEL), D_MODEL, 0.5),
        "ada_b": 0.02 * normal((DEPTH, 6 * D_MODEL)),
        "norm_mix_g": 1.0 + 0.05 * normal((DEPTH, D_MODEL)),
        "norm_ffn_g": 1.0 + 0.05 * normal((DEPTH, D_MODEL)),
        "final_norm_g": 1.0 + 0.05 * normal((D_MODEL,)),
        "conv_w_in": dense((N_CONV_LAYERS, D_MODEL, 3 * D_MODEL), D_MODEL),
        "conv_k": dense((N_CONV_LAYERS, 3, D_MODEL), 3),
        "conv_w_out": dense((N_CONV_LAYERS, D_MODEL, D_MODEL), D_MODEL),
        "attn_w_qkv": dense((N_ATTN_LAYERS, D_MODEL, qkv_w), D_MODEL),
        "attn_q_norm_g": 1.0 + 0.05 * normal((N_ATTN_LAYERS, HEAD_DIM)),
        "attn_k_norm_g": 1.0 + 0.05 * normal((N_ATTN_LAYERS, HEAD_DIM)),
        "attn_w_out": dense((N_ATTN_LAYERS, D_MODEL, D_MODEL), D_MODEL),
        "ret_w_in": dense((N_RET_LAYERS, D_MODEL, ret_in_w), D_MODEL),
        "ret_decay": RET_DECAY_BASE + jnp.arange(RET_HEADS, dtype=f32) + 0.1 * normal((N_RET_LAYERS, 2, RET_HEADS)),
        "ret_w_out": dense((N_RET_LAYERS, ret_v_w, D_MODEL), ret_v_w),
        "ffn_w_up": dense((DEPTH, D_MODEL, 2 * D_FF), D_MODEL),
        "ffn_conv_k": dense((DEPTH, 3, 2 * D_FF), 3),
        "ffn_conv_b": 0.02 * normal((DEPTH, 2 * D_FF)),
        "ffn_w_down": dense((DEPTH, D_FF, D_MODEL), D_FF),
    }


def reference(x, c, ctx, c_ctx, ada_w, ada_b, norm_mix_g, norm_ffn_g, final_norm_g,
              conv_w_in, conv_k, conv_w_out, attn_w_qkv, attn_q_norm_g, attn_k_norm_g, attn_w_out,
              ret_w_in, ret_decay, ret_w_out, ffn_w_up, ffn_conv_k, ffn_conv_b, ffn_w_down):
    S = x.shape[1]
    ROWS = S // GRID_W
    rows = jnp.repeat(jnp.arange(ROWS, dtype=jnp.float32), GRID_W)
    cols = jnp.tile(jnp.arange(GRID_W, dtype=jnp.float32), ROWS)
    attn_cos, attn_sin = axial_angles(rows, cols, HEAD_DIM)
    ret_cos, ret_sin = axial_angles(rows, cols, RET_HEAD_DIM)

    kinds = [i % N_MIXERS for i in range(DEPTH)]
    reads_ctx = [kd in (1, 2) for kd in kinds]
    silu_c = jax.nn.silu(c)
    silu_cc = jax.nn.silu(c_ctx)
    cx = ctx
    for i in range(DEPTH):
        kind = kinds[i]
        j = i // N_MIXERS
        ctx_out = any(reads_ctx[i + 1:])
        ctx_in = reads_ctx[i] or ctx_out
        sh_m, sc_m, g_m, sh_f, sc_f, g_f = [m[:, None, :] for m in jnp.split(silu_c @ ada_w[i] + ada_b[i], 6, axis=-1)]
        h = modulate(x, norm_mix_g[i], sh_m, sc_m)
        hc = None
        if ctx_in:
            shc_m, scc_m, gc_m, shc_f, scc_f, gc_f = jnp.split(silu_cc @ ada_w[i] + ada_b[i], 6, axis=-1)
            hc = modulate(cx, norm_mix_g[i], shc_m, scc_m)
        if kind == 0:
            y = short_conv_mixer(h, conv_w_in[j], conv_k[j], conv_w_out[j])
            yc = short_conv_mixer(hc, conv_w_in[j], conv_k[j], conv_w_out[j]) if ctx_out else None
        elif kind == 1:
            y, yc = gqa_mixer(h, hc, attn_w_qkv[j], attn_q_norm_g[j], attn_k_norm_g[j], attn_w_out[j],
                              attn_cos, attn_sin, ctx_out)
        else:
            y, yc = retention_mixer(h, hc, ret_w_in[j], ret_decay[j], ret_w_out[j],
                                    ret_cos, ret_sin, ctx_out)
        x = x + g_m * y
        x = x + g_f * conv_ffn(modulate(x, norm_ffn_g[i], sh_f, sc_f),
                               ffn_w_up[i], ffn_conv_k[i], ffn_conv_b[i], ffn_w_down[i])
        if ctx_out:
            cx = cx + gc_m * yc
            cx = cx + gc_f * conv_ffn(modulate(cx, norm_ffn_g[i], shc_f, scc_f),
                                      ffn_w_up[i], ffn_conv_k[i], ffn_conv_b[i], ffn_w_down[i])
    return rmsnorm(x, final_norm_g)
```

```cpp
#include <hip/hip_runtime.h>
#include <hip/hip_cooperative_groups.h>
#include <hip/hip_bf16.h>
#include <cmath>
#include <cstdio>
#include <cstdint>
namespace cg = cooperative_groups;

#define LAS __attribute__((address_space(3)))
typedef unsigned short bf16_t;
typedef short bf16x8 __attribute__((ext_vector_type(8)));
typedef short s16x4 __attribute__((ext_vector_type(4)));
typedef float f32x4 __attribute__((ext_vector_type(4)));
typedef float f32x2 __attribute__((ext_vector_type(2)));
typedef unsigned u32x4 __attribute__((ext_vector_type(4)));
typedef unsigned u32x2 __attribute__((ext_vector_type(2)));
typedef LAS unsigned char* ldsp;

#define PROBE_SYNC 0
#define PROBE_ATT 1
#define PROBE_RET 1
#define PROBE_GS 1
#define PROBE_EW 1
#define PROBE_GR 1
#define PROBE_GB 1
#define PROBE_PRO 1
#ifndef MK_PER_PHASE
#define MK_PER_PHASE 0
#endif

constexpr int D = 1024, NB = 8, SEQ = 2048, CL = 256, ML = NB * SEQ, MC = NB * CL, MT = ML + MC;
constexpr int DFF = 2816, DFF2 = 5632, NMOD = 6144;
constexpr float EPS = 1e-6f;
constexpr float C2 = 0.125f * 1.4426950408889634f;
constexpr float LOG2_THETA = 13.287712379549449f;
constexpr float INV_2PI = 0.15915494309189535f;

constexpr size_t MiB = 1u << 20;
constexpr size_t WS_MODS = 0;
constexpr size_t WS_CIN = 1 * MiB, WS_COUT = 13 * MiB, WS_AQKV = 17 * MiB, WS_AOUT = 20 * MiB, WS_RIN = 22 * MiB, WS_ROUT = 34 * MiB,
                 WS_UP = 38 * MiB, WS_DN = 82 * MiB;
constexpr size_t WS_XC = 104 * MiB;
constexpr size_t WS_H = 112 * MiB;
constexpr size_t WS_U = 148 * MiB;
constexpr size_t WS_RC = 340 * MiB;
constexpr size_t WS_SIDE = 352 * MiB;
constexpr size_t WS_CTL = 366 * MiB, CTL_BYTES = 262144, CTL_ZEROS = 16384;
constexpr size_t WS_PARTA = 346 * MiB, WS_PARTB = 367 * MiB;
constexpr size_t WS_XBUF = 365 * MiB;
constexpr size_t WS_END = 383 * MiB;
constexpr int LDS_BYTES = 163840, MISC_OFF = LDS_BYTES - 64;

__device__ __forceinline__ unsigned cvt_pk_bf16(float lo, float hi) { unsigned r; asm volatile("v_cvt_pk_bf16_f32 %0, %1, %2" : "=v"(r) : "v"(lo), "v"(hi)); return r; }
__device__ __forceinline__ float bflo(unsigned w) { return __uint_as_float(w << 16); }
__device__ __forceinline__ float bfhi(unsigned w) { return __uint_as_float(w & 0xffff0000u); }
__device__ __forceinline__ float wave_sum(float v) {
#pragma unroll
    for (int o = 1; o < 64; o <<= 1) v += __shfl_xor(v, o);
    return v;
}
__device__ __forceinline__ float silu_f(float x) { return x * __builtin_amdgcn_rcpf(1.0f + __builtin_amdgcn_exp2f(x * -1.4426950408889634f)); }
__device__ __forceinline__ f32x4 mfma16(bf16x8 a, bf16x8 b, f32x4 c) { return __builtin_amdgcn_mfma_f32_16x16x32_bf16(a, b, c, 0, 0, 0); }
typedef short v4i16_t __attribute__((ext_vector_type(4)));
__device__ __forceinline__ s16x4 lds_tr(ldsp p) { return __builtin_bit_cast(s16x4, __builtin_amdgcn_ds_read_tr16_b64_v4i16((LAS v4i16_t*)p)); }

namespace pg8 {
constexpr int BM = 256, BK = 64, HALF = 128, HTB = HALF * BK * 2, STAGE_BYTES = 8 * HTB, NXCD = 8, WGM = 8;
__device__ __forceinline__ int lds_byte(int r, int c) { const int st = (r >> 4) * 2 + (c >> 5), rr = r & 15, cc = c & 31, ob = rr * 64 + cc * 2; return st * 1024 + (ob ^ (((ob >> 9) & 1) << 5)); }
__device__ __forceinline__ void stage_rc(int b, int& R, int& C) { const int st = b / 1024, sb = b % 1024, swz = sb ^ (((sb >> 9) & 1) << 5); R = (st >> 1) * 16 + swz / 64; C = (st & 1) * 32 + (swz % 64) / 2; }
__device__ __forceinline__ int perm32(int rho) { const int n = rho >> 4, i = rho & 15; return 8 * (i >> 2) + 4 * n + (i & 3); }
struct Unit { int pm, pn; unsigned koff; int kq; };
struct Gemm { const bf16_t* A; const bf16_t* Bt; int M, N, K, lda, ldb; };
struct StaticOrder {
    int nM, nN, nwg, G, c, split, kq0; unsigned kpart, koff0;
    __device__ void init(int M, int N, int G_, int c_, int split_ = 1, unsigned kpart_ = 0u, unsigned koff0_ = 0u, int kq0_ = 0) { nM = M / BM; nN = N / BM; nwg = nM * nN; G = G_; c = c_; split = split_; kpart = kpart_; koff0 = koff0_; kq0 = kq0_; }
    __device__ __forceinline__ bool next(int i, Unit& u) const {
        const long L = (long)i * G + c;
        if (L >= (long)nwg * split) return false;
        int pm, pn, kq = 0; unsigned koff = 0u;
        if (split > 1) { kq = (int)(L % split); const int t = (int)(L / split); pm = t % nM; pn = t / nM; koff = koff0 + (unsigned)kq * kpart; }
        else {
            int wgid = (int)L; { const int q = nwg / NXCD, r = nwg % NXCD, xcd = wgid % NXCD, off = wgid / NXCD; wgid = (xcd < r ? xcd * (q + 1) : r * (q + 1) + (xcd - r) * q) + off; }
            const int nig = WGM * nN, gid = wgid / nig, fm = gid * WGM, gsz = (nM - fm) < WGM ? (nM - fm) : WGM;
            pm = fm + ((wgid % nig) % gsz); pn = (wgid % nig) / gsz; }
        u.pm = pm; u.pn = pn; u.koff = koff; u.kq = kq0 + kq; return true;
    }
};
struct EpiStore {
    static constexpr bool PERM = true, AFTER_DRAIN = false; static constexpr int BMAP = 0;
    bf16_t* O; int ldc; bf16_t* side; int scale_tiles; float scale;
    __device__ __forceinline__ void operator()(const f32x4 (&acc)[2][2][4][2], const Unit& u, int wr, int wc, int fr, int fq) const {
        char* base = (char*)(O + (size_t)(u.pm * BM) * ldc + u.pn * BM);
        char* sbase = (char*)(side + (size_t)(u.pm * 16) * ldc + u.pn * BM);
        const unsigned ldb = (unsigned)ldc * 2u; const float sc_ = (u.pn < scale_tiles) ? scale : 1.0f;
        unsigned off0 = (unsigned)(wr * 64 + fr) * ldb + (unsigned)(wc * 32 + 8 * fq) * 2u; asm volatile("" : "+v"(off0));
#pragma unroll
        for (int ai = 0; ai < 2; ++ai)
#pragma unroll
            for (int m = 0; m < 4; ++m) { const unsigned off = off0 + (unsigned)(ai * HALF + m * 16) * ldb;
#pragma unroll
                for (int bj = 0; bj < 2; ++bj) { const f32x4 v0 = acc[ai][bj][m][0] * sc_, v1 = acc[ai][bj][m][1] * sc_;
                    u32x4 w; w.x = cvt_pk_bf16(v0[0], v0[1]); w.y = cvt_pk_bf16(v0[2], v0[3]); w.z = cvt_pk_bf16(v1[0], v1[1]); w.w = cvt_pk_bf16(v1[2], v1[3]);
                    *(u32x4*)(base + off + bj * HALF * 2) = w;
                    if (side != nullptr && ((fr == 0 && (m & 1) == 0) || (fr == 15 && (m & 1) == 1))) {
                        const int slot = (ai * 4 + wr * 2 + (m >> 1)) * 2 + (m & 1);
                        *(u32x4*)(sbase + (unsigned)slot * ldb + (unsigned)(wc * 32 + 8 * fq) * 2u + bj * HALF * 2) = w; } } }
    }
};
struct EpiResid {
    static constexpr bool PERM = false, AFTER_DRAIN = false; static constexpr int BMAP = 0;
    const float* xs_lat; const float* xs_ctx; float* xd_lat; float* xd_ctx; const float* gate; int row_base; float* part;
    __device__ __forceinline__ void operator()(const f32x4 (&acc)[2][2][4][2], const Unit& u, int wr, int wc, int fr, int fq) const {
        const int rowt = row_base + u.pm * BM; const bool lat = rowt < ML;
        const int b = lat ? (rowt >> 11) : NB;
        const char* xs = (const char*)((lat ? xs_lat + (size_t)rowt * D : xs_ctx + (size_t)(rowt - ML) * D) + u.pn * BM);
        char* xd = (char*)((part != nullptr ? part + (size_t)u.kq * MC * D + (size_t)(rowt - ML) * D : lat ? xd_lat + (size_t)rowt * D : xd_ctx + (size_t)(rowt - ML) * D) + u.pn * BM);
        const char* gp = (const char*)(gate + (size_t)b * NMOD + u.pn * BM);
        const unsigned coff = (unsigned)(wc * 32 + 4 * fq) * 4u;
        unsigned off0 = (unsigned)(wr * 64 + fr) * (D * 4u) + coff; asm volatile("" : "+v"(off0));
#pragma unroll
        for (int bj = 0; bj < 2; ++bj)
#pragma unroll
            for (int n = 0; n < 2; ++n) { const f32x4 gv = *(const f32x4*)(gp + coff + (bj * HALF + n * 16) * 4);
#pragma unroll
                for (int ai = 0; ai < 2; ++ai) {
#pragma unroll
                    for (int m = 0; m < 4; ++m) { const unsigned off = off0 + (unsigned)((ai * HALF + m * 16) * D + bj * HALF + n * 16) * 4u;
                        if (part != nullptr) { *(f32x4*)(xd + off) = gv * acc[ai][bj][m][n]; }
                        else { const f32x4 xv = *(const f32x4*)(xs + off); *(f32x4*)(xd + off) = xv + gv * acc[ai][bj][m][n]; } }
                    } asm volatile("" ::: "memory"); }
    }
};

struct EpiRope {
    static constexpr bool PERM = false, AFTER_DRAIN = false; static constexpr int BMAP = 1;
    bf16_t* O; int ldc; int q_tiles;
    __device__ __forceinline__ void operator()(const f32x4 (&acc)[2][2][4][2], const Unit& u, int wr, int wc, int fr, int fq) const {
        char* base = (char*)(O + (size_t)(u.pm * BM) * ldc + u.pn * BM);
        const unsigned ldb = (unsigned)ldc * 2u; const float sc_ = (u.pn < q_tiles) ? 1.0f : 0.0625f;
        const int w0 = wc * 32 + 4 * fq;
        unsigned off0 = (unsigned)(wr * 64 + fr) * ldb + (unsigned)((w0 < 64 ? w0 : w0 + 64)) * 2u; asm volatile("" : "+v"(off0));
        float inv[2][4];
#pragma unroll
        for (int n = 0; n < 2; ++n)
#pragma unroll
            for (int j = 0; j < 4; ++j) inv[n][j] = __builtin_amdgcn_exp2f(-(float)((w0 + 16 * n + j) & 63) * (LOG2_THETA / 64.f)) * INV_2PI;
#pragma unroll
        for (int ai = 0; ai < 2; ++ai)
#pragma unroll
            for (int m = 0; m < 4; ++m) {
                int frl = fr; asm volatile("" : "+v"(frl));
                const int t = (u.pm * BM + ai * HALF + wr * 64 + m * 16 + frl) & (SEQ - 1);
                const float pos = (wc >= 2) ? (float)(t & 63) : (float)(t >> 6);
                const unsigned off = off0 + (unsigned)(ai * HALF + m * 16) * ldb;
#pragma unroll
                for (int n = 0; n < 2; ++n) { float o1[4], o2[4];
#pragma unroll
                    for (int j = 0; j < 4; ++j) { float tr = pos * inv[n][j]; tr -= rintf(tr);
                        const float sn = __builtin_amdgcn_sinf(tr), cs = __builtin_amdgcn_cosf(tr);
                        const float x1 = acc[ai][0][m][n][j], x2 = acc[ai][1][m][n][j];
                        o1[j] = (x1 * cs - x2 * sn) * sc_; o2[j] = (x1 * sn + x2 * cs) * sc_; }
                    u32x2 a1, a2; a1.x = cvt_pk_bf16(o1[0], o1[1]); a1.y = cvt_pk_bf16(o1[2], o1[3]); a2.x = cvt_pk_bf16(o2[0], o2[1]); a2.y = cvt_pk_bf16(o2[2], o2[3]);
                    *(u32x2*)(base + off + n * 32) = a1; *(u32x2*)(base + off + n * 32 + 128) = a2; } }
    }
};

struct EpiQKV {
    static constexpr bool PERM = false, AFTER_DRAIN = false; static constexpr int BMAP = 2;
    bf16_t* O; const float* qg; const float* kg;
    __device__ __forceinline__ void operator()(const f32x4 (&acc)[2][2][4][2], const Unit& u, int wr, int wc, int fr, int fq) const {
        constexpr int ldc = 1536;
        char* base = (char*)(O + (size_t)(u.pm * BM) * ldc + u.pn * BM + wc * 64);
        const unsigned ldb = (unsigned)ldc * 2u;
        unsigned off0 = (unsigned)(wr * 64 + fr) * ldb + (unsigned)(4 * fq) * 2u; asm volatile("" : "+v"(off0));
        const bool isv = u.pn == 5, isq = u.pn < 4, lat = u.pm < ML / BM;
        const float osc = isq ? C2 : 1.0f;
        const float* gp = isq ? qg : kg;
        float inv[4];
#pragma unroll
        for (int j = 0; j < 4; ++j) inv[j] = __builtin_amdgcn_exp2f(-(float)(4 * fq + j) * (LOG2_THETA / 16.f)) * INV_2PI;
#pragma unroll
        for (int ai = 0; ai < 2; ++ai)
#pragma unroll
            for (int m = 0; m < 4; ++m) {
                const unsigned off = off0 + (unsigned)(ai * HALF + m * 16) * ldb;
                float rstd = 1.0f;
                if (!isv) {
                    float ss = 0.f;
#pragma unroll
                    for (int n = 0; n < 2; ++n) { const f32x4 p = acc[ai][0][m][n], q = acc[ai][1][m][n];
                        ss += ((p[0] * p[0] + p[1] * p[1]) + (p[2] * p[2] + p[3] * p[3])) + ((q[0] * q[0] + q[1] * q[1]) + (q[2] * q[2] + q[3] * q[3])); }
                    ss += __shfl_xor(ss, 16); ss += __shfl_xor(ss, 32);
                    rstd = __builtin_amdgcn_rsqf(ss * (1.f / 64.f) + EPS);
                }
                int frl = fr; asm volatile("" : "+v"(frl));
                const int t = (u.pm * BM + ai * HALF + wr * 64 + m * 16 + frl) & (SEQ - 1);
#pragma unroll
                for (int n = 0; n < 2; ++n) {
                    f32x4 x1 = acc[ai][0][m][n], x2 = acc[ai][1][m][n];
                    if (!isv) {
                        x1 = x1 * rstd * *(const f32x4*)(gp + 32 * n + 4 * fq); x2 = x2 * rstd * *(const f32x4*)(gp + 32 * n + 4 * fq + 16);
                        if (lat) { const float pos = n ? (float)(t & 63) : (float)(t >> 6);
#pragma unroll
                            for (int j = 0; j < 4; ++j) { float tr = pos * inv[j]; tr -= rintf(tr);
                                const float sn = __builtin_amdgcn_sinf(tr), cs = __builtin_amdgcn_cosf(tr);
                                const float a1 = x1[j], a2 = x2[j]; x1[j] = a1 * cs - a2 * sn; x2[j] = a1 * sn + a2 * cs; } }
                        x1 = x1 * osc; x2 = x2 * osc;
                    }
                    u32x2 a1, a2; a1.x = cvt_pk_bf16(x1[0], x1[1]); a1.y = cvt_pk_bf16(x1[2], x1[3]); a2.x = cvt_pk_bf16(x2[0], x2[1]); a2.y = cvt_pk_bf16(x2[2], x2[3]);
                    *(u32x2*)(base + off + n * 64) = a1; *(u32x2*)(base + off + n * 64 + 32) = a2; }
                asm volatile("" ::: "memory"); }
    }
};

struct EpiGate {
    static constexpr bool PERM = true, AFTER_DRAIN = false; static constexpr int BMAP = 3;
    bf16_t* A2; bf16_t* side; const float* fk; const float* fb;
    __device__ __forceinline__ void operator()(const f32x4 (&acc)[2][2][4][2], const Unit& u, int wr, int wc, int fr_in, int fq_in) const {
        const int fr0_ = fr_in, fq0_ = fq_in;
        char* base = (char*)(A2 + (size_t)(u.pm * BM) * DFF);
        char* sbase = (char*)(side + (size_t)(u.pm * 16) * DFF2);
        int fr_l = fr0_, fq_l = fq0_; asm volatile("" : "+v"(fr_l), "+v"(fq_l));
        const int fr = fr_l, fq = fq_l;
        const int ch0 = u.pn * HALF + wc * 32 + 8 * fq;
        const unsigned off0 = (unsigned)(wr * 64 + fr) * (DFF * 2u) + (unsigned)ch0 * 2u;
        const bool f0 = fr == 0, f15 = fr == 15;
#define DPP_UP(v) __int_as_float(__builtin_amdgcn_update_dpp(0, __float_as_int(v), 0x121, 0xf, 0xf, false))
#define DPP_DN(v) __int_as_float(__builtin_amdgcn_update_dpp(0, __float_as_int(v), 0x12F, 0xf, 0xf, false))
#pragma unroll
        for (int ai = 0; ai < 2; ++ai) {
            f32x4 o[4]; u32x2 wlo[4];
#pragma unroll
            for (int n = 0; n < 2; ++n) {
                const int ch = ch0 + 4 * n;
#pragma unroll
                for (int pass = 0; pass < 2; ++pass) {
                    const int co = pass ? DFF : 0;
                    const f32x4 k0 = *(const f32x4*)(fk + co + ch), k1 = *(const f32x4*)(fk + DFF2 + co + ch), k2 = *(const f32x4*)(fk + 2 * DFF2 + co + ch), bb = *(const f32x4*)(fb + co + ch);
                    f32x4 up_prev = (f32x4){0.f, 0.f, 0.f, 0.f}, up_cur, dn_cur, dn_next;
#pragma unroll
                    for (int j = 0; j < 4; ++j) dn_cur[j] = DPP_DN(acc[ai][pass][0][n][j]);
#pragma unroll
                    for (int m = 0; m < 4; ++m) {
                        const f32x4 xv = acc[ai][pass][m][n];
#pragma unroll
                        for (int j = 0; j < 4; ++j) { up_cur[j] = DPP_UP(xv[j]); dn_next[j] = (m < 3) ? DPP_DN(acc[ai][pass][m < 3 ? m + 1 : 3][n][j]) : 0.f; }
                        const f32x4 xp = f0 ? up_prev : up_cur, xn = f15 ? dn_next : dn_cur;
                        const f32x4 c = (k0 * xp + k1 * xv) + (k2 * xn + bb);
                        if (pass == 0) o[m] = c;
                        else { f32x4 e;
#pragma unroll
                            for (int j = 0; j < 4; ++j) e[j] = __builtin_amdgcn_rcpf(1.0f + __builtin_amdgcn_exp2f(c[j] * -1.4426950408889634f));
                            o[m] = o[m] * (c * e); }
                        up_prev = up_cur; dn_cur = dn_next; }
                }
                if (n == 0) {
#pragma unroll
                    for (int m = 0; m < 4; ++m) { wlo[m].x = cvt_pk_bf16(o[m][0], o[m][1]); wlo[m].y = cvt_pk_bf16(o[m][2], o[m][3]); }
                } else {
#pragma unroll
                    for (int m = 0; m < 4; ++m) { u32x4 w; w.x = wlo[m].x; w.y = wlo[m].y; w.z = cvt_pk_bf16(o[m][0], o[m][1]); w.w = cvt_pk_bf16(o[m][2], o[m][3]);
                        *(u32x4*)(base + off0 + (unsigned)(ai * HALF + m * 16) * (DFF * 2u)) = w; }
                }
                if (fr < 2 || fr >= 14) { const int k = fr < 2 ? fr : fr - 12;
                    const f32x4 xv = fr < 2 ? acc[ai][0][0][n] : acc[ai][0][3][n], yv = fr < 2 ? acc[ai][1][0][n] : acc[ai][1][3][n];
                    char* sp = sbase + (size_t)((2 * ai + wr) * 4 + k) * (DFF2 * 2) + (size_t)ch * 2;
                    u32x2 a, b; a.x = cvt_pk_bf16(xv[0], xv[1]); a.y = cvt_pk_bf16(xv[2], xv[3]); b.x = cvt_pk_bf16(yv[0], yv[1]); b.y = cvt_pk_bf16(yv[2], yv[3]);
                    *(u32x2*)sp = a; *(u32x2*)(sp + DFF * 2) = b; }
            }
        }
#undef DPP_UP
#undef DPP_DN
    }
};

struct EpiResidNorm {
    static constexpr bool PERM = false, AFTER_DRAIN = true; static constexpr int BMAP = 0;
    const float* xs; float* xd; const float* gate;
    const float* gain; const float* modn; int shoff, scoff;
    bf16_t* H; unsigned* xbuf; unsigned* cnt; int fin;
    __device__ __forceinline__ void operator()(const f32x4 (&)[2][2][4][2], const Unit&, int, int, int, int) const {}
    __device__ __forceinline__ void fused(f32x4 (&acc)[2][2][4][2], const Unit& u, int wr, int wc, int fr, int fq, ldsp lds, int wid, int lane) const {
        const int rowt = u.pm * BM, b = rowt >> 11;
        const char* xsb = (const char*)(xs + (size_t)rowt * D + u.pn * BM);
        char* xdb = (char*)(xd + (size_t)rowt * D + u.pn * BM);
        const char* gp = (const char*)(gate + (size_t)b * NMOD + u.pn * BM);
        const unsigned coff = (unsigned)(wc * 32 + 4 * fq) * 4u;
        unsigned off0 = (unsigned)(wr * 64 + fr) * (D * 4u) + coff; asm volatile("" : "+v"(off0));
#pragma unroll
        for (int bj = 0; bj < 2; ++bj)
#pragma unroll
            for (int n = 0; n < 2; ++n) { const f32x4 gv = *(const f32x4*)(gp + coff + (bj * HALF + n * 16) * 4);
                f32x4 xv[2][4];
#pragma unroll
                for (int ai = 0; ai < 2; ++ai)
#pragma unroll
                    for (int m = 0; m < 4; ++m) xv[ai][m] = *(const f32x4*)(xsb + off0 + (unsigned)((ai * HALF + m * 16) * D + bj * HALF + n * 16) * 4u);
#pragma unroll
                for (int ai = 0; ai < 2; ++ai)
#pragma unroll
                    for (int m = 0; m < 4; ++m) acc[ai][bj][m][n] = xv[ai][m] + gv * acc[ai][bj][m][n];
                if (!fin) {
#pragma unroll
                    for (int ai = 0; ai < 2; ++ai)
#pragma unroll
                        for (int m = 0; m < 4; ++m) *(f32x4*)(xdb + off0 + (unsigned)((ai * HALF + m * 16) * D + bj * HALF + n * 16) * 4u) = acc[ai][bj][m][n];
                }
                asm volatile("" ::: "memory"); }
        LAS float* P = (LAS float*)lds;
        LAS float* Sx = (LAS float*)(lds + 4096);
#pragma unroll
        for (int ai = 0; ai < 2; ++ai)
#pragma unroll
            for (int m = 0; m < 4; ++m) { float sq = 0.f;
#pragma unroll
                for (int bj = 0; bj < 2; ++bj)
#pragma unroll
                    for (int n = 0; n < 2; ++n) { const f32x4 v = acc[ai][bj][m][n]; sq += (v[0] * v[0] + v[1] * v[1]) + (v[2] * v[2] + v[3] * v[3]); }
                sq += __shfl_xor(sq, 16); sq += __shfl_xor(sq, 32);
                if (fq == 0) P[(ai * HALF + wr * 64 + m * 16 + fr) * 4 + wc] = sq; }
        asm volatile("s_waitcnt lgkmcnt(0)" ::: "memory"); __builtin_amdgcn_s_barrier(); asm volatile("" ::: "memory");
        const int row = wid * 32 + (lane & 31);
        unsigned* slot = xbuf + ((size_t)(u.pm * BM + row)) * 4;
        if (lane < 32) { const float t = ((P[row * 4 + 0] + P[row * 4 + 1]) + P[row * 4 + 2]) + P[row * 4 + 3];
            __hip_atomic_store(slot + u.pn, __float_as_uint(t), __ATOMIC_RELAXED, __HIP_MEMORY_SCOPE_AGENT); }
        asm volatile("s_waitcnt vmcnt(0)" ::: "memory");
        if (lane == 0) __hip_atomic_fetch_add(cnt + 64 * u.pm, 1u, __ATOMIC_RELAXED, __HIP_MEMORY_SCOPE_AGENT);
        if (wid == 0) { unsigned sp = 0u;
            while ((unsigned)__builtin_amdgcn_readfirstlane(__hip_atomic_load(cnt + 64 * u.pm, __ATOMIC_RELAXED, __HIP_MEMORY_SCOPE_AGENT)) < 32u) { __builtin_amdgcn_s_sleep(2); if (++sp > (1u << 22)) break; }
            __builtin_amdgcn_fence(__ATOMIC_ACQUIRE, "agent"); }
        asm volatile("s_waitcnt vmcnt(0) lgkmcnt(0)" ::: "memory"); __builtin_amdgcn_s_barrier(); asm volatile("" ::: "memory");
        if (lane < 32) {
            const float t0 = __uint_as_float(__hip_atomic_load(slot + 0, __ATOMIC_RELAXED, __HIP_MEMORY_SCOPE_AGENT)), t1 = __uint_as_float(__hip_atomic_load(slot + 1, __ATOMIC_RELAXED, __HIP_MEMORY_SCOPE_AGENT));
            const float t2 = __uint_as_float(__hip_atomic_load(slot + 2, __ATOMIC_RELAXED, __HIP_MEMORY_SCOPE_AGENT)), t3 = __uint_as_float(__hip_atomic_load(slot + 3, __ATOMIC_RELAXED, __HIP_MEMORY_SCOPE_AGENT));
            Sx[row] = 1.0f / sqrtf((((t0 + t1) + t2) + t3) * (1.f / D) + EPS); }
        asm volatile("s_waitcnt vmcnt(0) lgkmcnt(0)" ::: "memory"); __builtin_amdgcn_s_barrier(); asm volatile("" ::: "memory");
        const int colt = u.pn * BM + wc * 32 + 4 * fq;
        const float* mb = modn + (size_t)b * NMOD;
#pragma unroll
        for (int bj = 0; bj < 2; ++bj)
#pragma unroll
            for (int n = 0; n < 2; ++n) { const int c = colt + bj * HALF + n * 16;
                f32x4 gc = *(const f32x4*)(gain + c), sh = (f32x4){0.f, 0.f, 0.f, 0.f};
                if (!fin) { gc = gc * (*(const f32x4*)(mb + scoff + c) + 1.0f); sh = *(const f32x4*)(mb + shoff + c); }
#pragma unroll
                for (int ai = 0; ai < 2; ++ai)
#pragma unroll
                    for (int m = 0; m < 4; ++m) { const int r = ai * HALF + wr * 64 + m * 16 + fr; const float rs = Sx[r];
                        const f32x4 y = (acc[ai][bj][m][n] * rs) * gc + sh;
                        if (fin) *(f32x4*)(xd + (size_t)(rowt + r) * D + c) = y;
                        else { u32x2 w; w.x = cvt_pk_bf16(y[0], y[1]); w.y = cvt_pk_bf16(y[2], y[3]); *(u32x2*)(H + (size_t)(rowt + r) * D + c) = w; } } }
        asm volatile("s_waitcnt lgkmcnt(0)" ::: "memory"); __builtin_amdgcn_s_barrier(); asm volatile("" ::: "memory");
    }
};

template <class Epi>
__device__ __forceinline__ void gemm_phase(ldsp lds, const Gemm g, const StaticOrder& S, const Epi& E, const int tid) {
    const int wid = __builtin_amdgcn_readfirstlane(tid >> 6), lane = tid & 63, wr = wid >> 2, wc = wid & 3, fr = lane & 15, fq = lane >> 4;
    const int K = g.K, nt = K / BK, lda = g.lda;
    unsigned voffA[2], voffB[2];
#pragma unroll
    for (int i = 0; i < 2; ++i) { int R, C; stage_rc(tid * 16 + i * 8192, R, C); const int Rb = Epi::PERM ? ((R & ~31) + perm32(R & 31)) : (Epi::BMAP == 1 ? (R + (R >= 64 ? 64 : 0)) : Epi::BMAP == 2 ? ((R >> 5) * 64 + (R & 15) + ((R & 16) ? 32 : 0)) : R);
        voffA[i] = (unsigned)(R * lda + C) * 2u; voffB[i] = (unsigned)(Rb * g.ldb + C) * 2u; }
    const size_t kstep = (size_t)(BK * 2);
    const size_t hstepA = (size_t)HALF * lda * 2, hstepB = (size_t)(Epi::BMAP == 1 ? 64 : Epi::BMAP == 2 ? 16 : Epi::BMAP == 3 ? DFF : HALF) * g.ldb * 2;
    const size_t tstepA = 2 * hstepA, tstepB = (size_t)(Epi::BMAP == 3 ? HALF : BM) * g.ldb * 2;
    const unsigned ldsw = (unsigned)wid * 1024u;
    const int aoff = lds_byte(wr * 64 + fr, fq * 8), boff = lds_byte(wc * 32 + fr, fq * 8);
#define PG8_SA(b, h) (((b) * 2 + (h)) * HTB)
#define PG8_SB(b, h) ((4 + (b) * 2 + (h)) * HTB)
#define PG8_STAGE(bufoff, gbase, voff) do { _Pragma("unroll") for (int _i = 0; _i < 2; ++_i) \
        __builtin_amdgcn_global_load_lds((const unsigned*)((const char*)(gbase) + (voff)[_i]), (LAS unsigned*)(lds + (bufoff) + ldsw + _i * 8192), 16, 0, 0); } while (0)
#define PG8_LDA(dst, b, h) do { _Pragma("unroll") for (int m = 0; m < 4; ++m) _Pragma("unroll") for (int k = 0; k < 2; ++k) dst[m][k] = *(const LAS bf16x8*)(lds + PG8_SA(b, h) + aoff + m * 2048 + k * 1024); } while (0)
#define PG8_LDB(dst, b, h) do { _Pragma("unroll") for (int n = 0; n < 2; ++n) _Pragma("unroll") for (int k = 0; k < 2; ++k) dst[n][k] = *(const LAS bf16x8*)(lds + PG8_SB(b, h) + boff + n * 2048 + k * 1024); } while (0)
#define PG8_MMA(ai, bj, At, Bt) do { __builtin_amdgcn_s_setprio(1); _Pragma("unroll") for (int m = 0; m < 4; ++m) _Pragma("unroll") for (int n = 0; n < 2; ++n) _Pragma("unroll") for (int k = 0; k < 2; ++k) \
        acc[ai][bj][m][n] = __builtin_amdgcn_mfma_f32_16x16x32_bf16(Bt[n][k], At[m][k], acc[ai][bj][m][n], 0, 0, 0); __builtin_amdgcn_s_setprio(0); } while (0)
#define PG8_WAIT_V(n) asm volatile("s_waitcnt vmcnt(" #n ")" ::: "memory")
#define PG8_WAIT_L(n) asm volatile("s_waitcnt lgkmcnt(" #n ")" ::: "memory")
#define PG8_BAR __builtin_amdgcn_s_barrier()
#define PG8_SCHED __builtin_amdgcn_sched_barrier(0)
    Unit cur, nxt; int ui = 0;
    if (!S.next(0, cur)) return;
    f32x4 acc[2][2][4][2];
#pragma unroll
    for (int a = 0; a < 2; ++a)
#pragma unroll
        for (int b = 0; b < 2; ++b)
#pragma unroll
            for (int m = 0; m < 4; ++m)
#pragma unroll
                for (int n = 0; n < 2; ++n) acc[a][b][m][n] = (f32x4){0.f, 0.f, 0.f, 0.f};
    bf16x8 At[4][2], B0[2][2], B1[2][2];
    const char* cA = (const char*)g.A + (size_t)cur.pm * tstepA + cur.koff; const char* cB = (const char*)g.Bt + (size_t)cur.pn * tstepB + cur.koff;
    PG8_STAGE(PG8_SB(0, 0), cB, voffB); PG8_STAGE(PG8_SB(0, 1), cB + hstepB, voffB); PG8_STAGE(PG8_SA(0, 0), cA, voffA); PG8_STAGE(PG8_SA(0, 1), cA + hstepA, voffA);
    if (wr == 1) PG8_BAR;
    PG8_WAIT_V(2); PG8_BAR;
    PG8_STAGE(PG8_SB(1, 0), cB + kstep, voffB); PG8_STAGE(PG8_SA(1, 0), cA + kstep, voffA); PG8_STAGE(PG8_SB(1, 1), cB + hstepB + kstep, voffB);
    PG8_WAIT_V(6); PG8_BAR;
    for (;;) {
        const bool has_next = S.next(ui + 1, nxt);
        const char* nA = has_next ? (const char*)g.A + (size_t)nxt.pm * tstepA + nxt.koff : cA; const char* nB = has_next ? (const char*)g.Bt + (size_t)nxt.pn * tstepB + nxt.koff : cB;
        for (int t = 0; t < nt; t += 2) {
            const bool last = (t == nt - 2);
            const char* a1 = cA + (size_t)(t + 1) * kstep;
            const char* a2 = last ? nA : cA + (size_t)(t + 2) * kstep; const char* b2 = last ? nB : cB + (size_t)(t + 2) * kstep;
            const char* a3 = a2 + kstep; const char* b3 = b2 + kstep;
            PG8_LDB(B0, 0, 0); PG8_LDB(B1, 0, 1); PG8_SCHED; PG8_LDA(At, 0, 0); PG8_STAGE(PG8_SA(1, 1), a1 + hstepA, voffA);
            PG8_WAIT_V(8); PG8_WAIT_L(0); PG8_BAR; PG8_MMA(0, 0, At, B0); PG8_MMA(0, 1, At, B1); PG8_BAR; PG8_SCHED;
            PG8_LDA(At, 0, 1); PG8_STAGE(PG8_SB(0, 0), b2, voffB); PG8_STAGE(PG8_SB(0, 1), b2 + hstepB, voffB); PG8_STAGE(PG8_SA(0, 0), a2, voffA);
            PG8_WAIT_V(8); PG8_WAIT_L(0); PG8_BAR; PG8_MMA(1, 0, At, B0); PG8_MMA(1, 1, At, B1); PG8_BAR; PG8_SCHED;
            PG8_LDB(B0, 1, 0); PG8_LDB(B1, 1, 1); PG8_SCHED; PG8_LDA(At, 1, 0); PG8_STAGE(PG8_SA(0, 1), a2 + hstepA, voffA);
            PG8_WAIT_V(8); PG8_WAIT_L(0); PG8_BAR; PG8_MMA(0, 0, At, B0); PG8_MMA(0, 1, At, B1); PG8_BAR; PG8_SCHED;
            PG8_LDA(At, 1, 1); PG8_STAGE(PG8_SB(1, 0), b3, voffB); PG8_STAGE(PG8_SB(1, 1), b3 + hstepB, voffB); PG8_STAGE(PG8_SA(1, 0), a3, voffA);
            PG8_WAIT_V(8); PG8_WAIT_L(0); PG8_BAR; PG8_MMA(1, 0, At, B0); PG8_MMA(1, 1, At, B1); PG8_BAR; PG8_SCHED;
        }
        if (wr == 0) PG8_BAR;
        if constexpr (!Epi::AFTER_DRAIN) E(acc, cur, wr, wc, fr, fq);
        if (!has_next) break;
#pragma unroll
        for (int a = 0; a < 2; ++a)
#pragma unroll
            for (int b = 0; b < 2; ++b)
#pragma unroll
                for (int m = 0; m < 4; ++m)
#pragma unroll
                    for (int n = 0; n < 2; ++n) acc[a][b][m][n] = (f32x4){0.f, 0.f, 0.f, 0.f};
        cur = nxt; cA = nA; cB = nB; ++ui;
        if (wr == 1) PG8_BAR;
    }
    PG8_WAIT_V(0);
    PG8_BAR;
    if constexpr (Epi::AFTER_DRAIN) E.fused(acc, cur, wr, wc, fr, fq, lds, wid, lane);
#undef PG8_SA
#undef PG8_SB
#undef PG8_STAGE
#undef PG8_LDA
#undef PG8_LDB
#undef PG8_MMA
#undef PG8_WAIT_V
#undef PG8_WAIT_L
#undef PG8_BAR
#undef PG8_SCHED
}
}

struct Args {
    const float *x, *c, *ctx, *c_ctx, *ada_w, *ada_b, *norm_mix_g, *norm_ffn_g, *final_g, *conv_w_in, *conv_k, *conv_w_out, *attn_w_qkv, *attn_qg, *attn_kg,
        *attn_w_out, *ret_w_in, *ret_decay, *ret_w_out, *ffn_w_up, *ffn_conv_k, *ffn_conv_b, *ffn_w_down;
    float* out; unsigned char* ws;
    int ph_lo, ph_hi, coop, pad;
};

__device__ __forceinline__ unsigned f2bf(float f) { unsigned u = __builtin_bit_cast(unsigned, f); return (u + 0x7fffu + ((u >> 16) & 1u)) >> 16; }
__device__ __forceinline__ unsigned pk2(float lo, float hi) { return f2bf(lo) | (f2bf(hi) << 16); }
__device__ __forceinline__ void transpose_item(const float* W, int K, int N, bf16_t* WT, LAS float* scr, int item, int lane) {
    const int nblk = N / 32, kb = item / nblk, nb = item % nblk, k0 = 64 * kb, n0 = 32 * nb;
    float wv[32];
#pragma unroll
    for (int i = 0; i < 32; ++i) wv[i] = W[(size_t)(k0 + 2 * i + (lane >> 5)) * N + n0 + (lane & 31)];
#pragma unroll
    for (int i = 0; i < 32; ++i) scr[(2 * i + (lane >> 5)) * 33 + (lane & 31)] = wv[i];
    asm volatile("s_waitcnt lgkmcnt(0)" ::: "memory");
    const int c = lane & 7;
#pragma unroll
    for (int j = 0; j < 4; ++j) { const int n = (lane >> 3) + 8 * j; const LAS float* s = scr + (8 * c) * 33 + n;
        u32x4 o; o.x = pk2(s[0 * 33], s[1 * 33]); o.y = pk2(s[2 * 33], s[3 * 33]); o.z = pk2(s[4 * 33], s[5 * 33]); o.w = pk2(s[6 * 33], s[7 * 33]);
        *(u32x4*)(WT + (size_t)(n0 + n) * K + k0 + 8 * c) = o; }
    asm volatile("s_waitcnt lgkmcnt(0)" ::: "memory");
}

__device__ __forceinline__ void transpose_flat(const __attribute__((address_space(4))) Args& a, LAS float* scr, int it, int lane) {
    unsigned char* ws = a.ws;
    const float* W; int K, N; bf16_t* WT;
    if (it < 3072) { const int mi = it / 1536; it -= mi * 1536; W = a.conv_w_in + (size_t)mi * D * 3072; K = D; N = 3072; WT = (bf16_t*)(ws + WS_CIN) + (size_t)mi * 3072 * D; }
    else if (it < 4096) { it -= 3072; const int mi = it / 512; it -= mi * 512; W = a.conv_w_out + (size_t)mi * D * D; K = D; N = D; WT = (bf16_t*)(ws + WS_COUT) + (size_t)mi * D * D; }
    else if (it < 4864) { it -= 4096; W = a.attn_w_qkv; K = D; N = 1536; WT = (bf16_t*)(ws + WS_AQKV); }
    else if (it < 5376) { it -= 4864; W = a.attn_w_out; K = D; N = D; WT = (bf16_t*)(ws + WS_AOUT); }
    else if (it < 8448) { it -= 5376; W = a.ret_w_in; K = D; N = 6144; WT = (bf16_t*)(ws + WS_RIN); }
    else if (it < 9472) { it -= 8448; W = a.ret_w_out; K = 2048; N = D; WT = (bf16_t*)(ws + WS_ROUT); }
    else if (it < 20736) { it -= 9472; const int mi = it / 2816; it -= mi * 2816; W = a.ffn_w_up + (size_t)mi * D * DFF2; K = D; N = DFF2; WT = (bf16_t*)(ws + WS_UP) + (size_t)mi * DFF2 * D; }
    else { it -= 20736; const int mi = it / 1408; it -= mi * 1408; W = a.ffn_w_down + (size_t)mi * DFF * D; K = DFF; N = D; WT = (bf16_t*)(ws + WS_DN) + (size_t)mi * D * DFF; }
    transpose_item(W, K, N, WT, scr, it, lane);
}
__device__ __forceinline__ void convert_set(const __attribute__((address_space(4))) Args& a, ldsp lds, int set, int w, int nw, int wave, int lane) {
    LAS float* scr = (LAS float*)(lds + wave * 8704);
    int s0, l0, s1, l1, s2, l2, s3, l3, s4, l4;
    if (set == 0) { s0 = 0; l0 = 1536; s1 = 3072; l1 = 512; s2 = 9472; l2 = 2816; s3 = 20736; l3 = 1408; s4 = 0; l4 = 0; }
    else if (set == 1) { s0 = 4096; l0 = 1280; s1 = 12288; l1 = 2816; s2 = 0; l2 = 0; s3 = 0; l3 = 0; s4 = 0; l4 = 0; }
    else if (set == 2) { s0 = 22144; l0 = 1408; s1 = 5376; l1 = 4096; s2 = 15104; l2 = 2816; s3 = 0; l3 = 0; s4 = 0; l4 = 0; }
    else { s0 = 23552; l0 = 1408; s1 = 1536; l1 = 1536; s2 = 3584; l2 = 512; s3 = 17920; l3 = 2816; s4 = 24960; l4 = 1408; }
    const int total = l0 + l1 + l2 + l3 + l4;
    for (int j = w; j < total; j += nw) {
        int r = j, it;
        if (r < l0) it = s0 + r; else { r -= l0;
            if (r < l1) it = s1 + r; else { r -= l1;
                if (r < l2) it = s2 + r; else { r -= l2;
                    if (r < l3) it = s3 + r; else it = s4 + (r - l3); } } }
        transpose_flat(a, scr, it, lane);
    }
}
__device__ __forceinline__ void prologue(const __attribute__((address_space(4))) Args& a, ldsp lds, int gw, int NGW, int wave, int lane, const int tid, const int bid, const int G) {
    LAS float* scr = (LAS float*)(lds + wave * 8704);
    unsigned char* ws = a.ws;
    convert_set(a, lds, 0, gw, NGW, wave, lane);
    if (G != 256) { for (int cs = 1; cs < 4; ++cs) convert_set(a, lds, cs, gw, NGW, wave, lane); }
    { const f32x4* src = (const f32x4*)a.ctx; f32x4* dst = (f32x4*)(ws + WS_XC); for (int i = gw * 64 + lane; i < MC * D / 4; i += NGW * 64) dst[i] = src[i]; }
    if (bid == 0 && tid < 8) ((float*)(ws + WS_MODS))[4 * 9 * NMOD + tid] = __builtin_amdgcn_logf(1.0f - __builtin_amdgcn_exp2f(-a.ret_decay[tid]));
    __syncthreads();
    LAS float* sc = (LAS float*)(lds + 69632);
    LAS float* red = (LAS float*)(lds + 106496);
    for (int i = tid; i < 9 * D; i += 512) { const float v = (i < 8 * D) ? a.c[i] : a.c_ctx[i - 8 * D]; sc[i] = silu_f(v); }
    __syncthreads();
    float* mods = (float*)(ws + WS_MODS);
    for (int u = bid; u < 4 * 96; u += G) {
        const int layer = u / 96, col0 = (u % 96) * 64;
        const float* Wl = a.ada_w + (size_t)layer * D * NMOD + col0 + lane;
        float acc[9];
#pragma unroll
        for (int j = 0; j < 9; ++j) acc[j] = 0.f;
        for (int k = wave * 128; k < wave * 128 + 128; k += 16) {
            float wv[16];
#pragma unroll
            for (int q = 0; q < 16; ++q) wv[q] = Wl[(size_t)(k + q) * NMOD];
#pragma unroll
            for (int q4 = 0; q4 < 4; ++q4)
#pragma unroll
                for (int j = 0; j < 9; ++j) { const f32x4 s4 = *(const LAS f32x4*)(sc + j * D + k + 4 * q4); acc[j] += s4[0] * wv[4 * q4] + s4[1] * wv[4 * q4 + 1] + s4[2] * wv[4 * q4 + 2] + s4[3] * wv[4 * q4 + 3]; }
        }
#pragma unroll
        for (int j = 0; j < 9; ++j) red[(wave * 9 + j) * 64 + lane] = acc[j];
        __syncthreads();
        for (int i = tid; i < 9 * 64; i += 512) { const int j = i >> 6, cc = i & 63; float s = a.ada_b[layer * NMOD + col0 + cc];
#pragma unroll
            for (int w = 0; w < 8; ++w) s += red[(w * 9 + j) * 64 + cc];
            mods[((size_t)layer * 9 + j) * NMOD + col0 + cc] = s; }
        __syncthreads();
    }
}

__device__ __forceinline__ void norm_phase(const float* xs_lat, const float* xs_ctx, const float* partA, const float* partB, float* xc_wr, int row_begin, int rows, const float* gain, const float* modl, int shoff, int scoff, bf16_t* H, int gw, int NGW, int lane) {
    for (int row0 = row_begin + gw; row0 < rows; row0 += 2 * NGW) {
        f32x4 v[2][4]; bool ok[2], latv[2];
#pragma unroll
        for (int u = 0; u < 2; ++u) { const int row = row0 + u * NGW; ok[u] = row < rows; const bool lat = row < ML; latv[u] = lat;
            if (ok[u]) { const f32x4* xr = (const f32x4*)(lat ? xs_lat + (size_t)row * D : xs_ctx + (size_t)(row - ML) * D) + lane;
#pragma unroll
                for (int j = 0; j < 4; ++j) v[u][j] = xr[64 * j]; } }
#pragma unroll
        for (int u = 0; u < 2; ++u) if (ok[u]) {
            const int row = row0 + u * NGW; const bool lat = latv[u]; const int b = lat ? (row >> 11) : NB;
            if (!lat && partA != nullptr) {
                const size_t ro = (size_t)(row - ML) * D;
#pragma unroll
                for (int j = 0; j < 4; ++j) { const int ix = 64 * j + lane;
                    v[u][j] = (((v[u][j] + ((const f32x4*)(partA + ro))[ix]) + ((const f32x4*)(partA + (size_t)MC * D + ro))[ix]) + ((const f32x4*)(partB + ro))[ix]) + ((const f32x4*)(partB + (size_t)MC * D + ro))[ix];
                    ((f32x4*)(xc_wr + ro))[ix] = v[u][j]; }
            }
            float s = 0.f;
#pragma unroll
            for (int j = 0; j < 4; ++j) s += (v[u][j][0] * v[u][j][0] + v[u][j][1] * v[u][j][1]) + (v[u][j][2] * v[u][j][2] + v[u][j][3] * v[u][j][3]);
            const float rstd = 1.0f / sqrtf(wave_sum(s) * (1.f / D) + EPS);
            const float* mb = modl + (size_t)b * NMOD;
            u32x2* o8 = (u32x2*)(H + (size_t)row * D) + lane;
#pragma unroll
            for (int j = 0; j < 4; ++j) { const int c = 4 * (lane + 64 * j);
                const f32x4 g4 = *(const f32x4*)(gain + c), sc4 = *(const f32x4*)(mb + scoff + c), sh4 = *(const f32x4*)(mb + shoff + c);
                const f32x4 y = (v[u][j] * rstd * g4) * (sc4 + 1.0f) + sh4;
                u32x2 w; w.x = cvt_pk_bf16(y[0], y[1]); w.y = cvt_pk_bf16(y[2], y[3]); o8[64 * j] = w; }
        }
    }
}
__device__ __forceinline__ void final_phase(float* x, const float* gain, int gw, int NGW, int lane) {
    for (int row0 = gw; row0 < ML; row0 += 2 * NGW) {
        f32x4 v[2][4];
#pragma unroll
        for (int u = 0; u < 2; ++u) { const f32x4* xr = (const f32x4*)(x + (size_t)(row0 + u * NGW) * D) + lane;
#pragma unroll
            for (int j = 0; j < 4; ++j) v[u][j] = xr[64 * j]; }
#pragma unroll
        for (int u = 0; u < 2; ++u) { f32x4* xr = (f32x4*)(x + (size_t)(row0 + u * NGW) * D) + lane; float s = 0.f;
#pragma unroll
            for (int j = 0; j < 4; ++j) s += (v[u][j][0] * v[u][j][0] + v[u][j][1] * v[u][j][1]) + (v[u][j][2] * v[u][j][2] + v[u][j][3] * v[u][j][3]);
            const float rstd = 1.0f / sqrtf(wave_sum(s) * (1.f / D) + EPS);
#pragma unroll
            for (int j = 0; j < 4; ++j) { const f32x4 g4 = *(const f32x4*)(gain + 4 * (lane + 64 * j)); xr[64 * j] = v[u][j] * rstd * g4; } }
    }
}
__device__ __forceinline__ void convgate_phase(const bf16_t* U, bf16_t* H, int rows, const float* ck, int gw, int NGW, int lane) {
    for (int row = gw; row < rows; row += NGW) {
        const bool lat = row < ML; const int t = lat ? (row & (SEQ - 1)) : ((row - ML) & (CL - 1)); const int L = lat ? SEQ : CL;
        const bool hasp = t > 0, hasn = t < L - 1;
        const bf16_t* ur = U + (size_t)row * 3072;
        u32x4 bq[2], cq[2], vq[2], cp[2], vp[2], cn[2], vn[2];
#pragma unroll
        for (int hf = 0; hf < 2; ++hf) {
            const int c0 = lane * 16 + hf * 8;
            bq[hf] = *(const u32x4*)(ur + c0); cq[hf] = *(const u32x4*)(ur + 1024 + c0); vq[hf] = *(const u32x4*)(ur + 2048 + c0);
            cp[hf] = (u32x4){0, 0, 0, 0}; vp[hf] = cp[hf]; cn[hf] = cp[hf]; vn[hf] = cp[hf];
            if (hasp) { cp[hf] = *(const u32x4*)(ur - 3072 + 1024 + c0); vp[hf] = *(const u32x4*)(ur - 3072 + 2048 + c0); }
            if (hasn) { cn[hf] = *(const u32x4*)(ur + 3072 + 1024 + c0); vn[hf] = *(const u32x4*)(ur + 3072 + 2048 + c0); }
        }
#pragma unroll
        for (int hf = 0; hf < 2; ++hf) {
            const int c0 = lane * 16 + hf * 8;
            u32x4 ow;
#pragma unroll
            for (int e = 0; e < 4; ++e) {
                const f32x2 w0 = *(const f32x2*)(ck + c0 + 2 * e), w1 = *(const f32x2*)(ck + D + c0 + 2 * e), w2 = *(const f32x2*)(ck + 2 * D + c0 + 2 * e);
                const float lo = bflo(bq[hf][e]) * (w0[0] * (bflo(cp[hf][e]) * bflo(vp[hf][e])) + w1[0] * (bflo(cq[hf][e]) * bflo(vq[hf][e])) + w2[0] * (bflo(cn[hf][e]) * bflo(vn[hf][e])));
                const float hi = bfhi(bq[hf][e]) * (w0[1] * (bfhi(cp[hf][e]) * bfhi(vp[hf][e])) + w1[1] * (bfhi(cq[hf][e]) * bfhi(vq[hf][e])) + w2[1] * (bfhi(cn[hf][e]) * bfhi(vn[hf][e])));
                ow[e] = cvt_pk_bf16(lo, hi);
            }
            *(u32x4*)(H + (size_t)row * D + c0) = ow;
        }
    }
}
__device__ __forceinline__ void ffngate_a(const bf16_t* U, bf16_t* SIDE, int rows, int gtid, int NTH) {
    const int n = (rows / 32) * 2 * 704;
    for (int i = gtid; i < n; i += NTH) { const int c8 = i % 704, cw = i / 704, row = 32 * (cw >> 1) + ((cw & 1) ? 31 : 0);
        *(u32x4*)(SIDE + (size_t)cw * DFF2 + c8 * 8) = *(const u32x4*)(U + (size_t)row * DFF2 + c8 * 8); }
}
__device__ __forceinline__ void ffngate_b(bf16_t* U, bf16_t* DST, size_t dmask, const bf16_t* SIDE, int rows, const float* fk, const float* fb, int gw, int NGW, int lane) {
    const int ntask = (rows / 32) * 11;
    for (int wt = gw; wt < ntask; wt += NGW) {
        const int c = wt / 11, s = wt % 11, ch = 256 * s + 4 * lane, r0 = 32 * c;
        const bool lat = r0 < ML; const int t0 = lat ? (r0 & (SEQ - 1)) : ((r0 - ML) & (CL - 1)); const int L = lat ? SEQ : CL;
        const bool first = (t0 == 0), lastc = (t0 + 32 == L);
        const f32x4 kv0 = *(const f32x4*)(fk + ch), kv1 = *(const f32x4*)(fk + DFF2 + ch), kv2 = *(const f32x4*)(fk + 2 * DFF2 + ch);
        const f32x4 kg0 = *(const f32x4*)(fk + DFF + ch), kg1 = *(const f32x4*)(fk + DFF2 + DFF + ch), kg2 = *(const f32x4*)(fk + 2 * DFF2 + DFF + ch);
        const f32x4 bv = *(const f32x4*)(fb + ch), bg = *(const f32x4*)(fb + DFF + ch);
        f32x4 pv = (f32x4){0.f, 0.f, 0.f, 0.f}, pg = pv, cv, cgt;
        if (!first) { const bf16_t* sp = SIDE + (size_t)((c - 1) * 2 + 1) * DFF2 + ch; const u32x2 a = *(const u32x2*)sp, b = *(const u32x2*)(sp + DFF);
            pv = (f32x4){bflo(a.x), bfhi(a.x), bflo(a.y), bfhi(a.y)}; pg = (f32x4){bflo(b.x), bfhi(b.x), bflo(b.y), bfhi(b.y)}; }
        { const bf16_t* up = U + (size_t)r0 * DFF2 + ch; const u32x2 a = *(const u32x2*)up, b = *(const u32x2*)(up + DFF);
            cv = (f32x4){bflo(a.x), bfhi(a.x), bflo(a.y), bfhi(a.y)}; cgt = (f32x4){bflo(b.x), bfhi(b.x), bflo(b.y), bfhi(b.y)}; }
        for (int rb = 0; rb < 4; ++rb) {
            u32x2 nv[8], ng[8];
#pragma unroll
            for (int i = 0; i < 8; ++i) { const int rr = 8 * rb + i + 1;
                const bf16_t* p = (rr < 32) ? U + (size_t)(r0 + rr) * DFF2 + ch : SIDE + (size_t)((lastc ? c : c + 1) * 2) * DFF2 + ch;
                nv[i] = *(const u32x2*)p; ng[i] = *(const u32x2*)(p + DFF); }
#pragma unroll
            for (int i = 0; i < 8; ++i) { const int rr = 8 * rb + i + 1;
                f32x4 xv = (f32x4){bflo(nv[i].x), bfhi(nv[i].x), bflo(nv[i].y), bfhi(nv[i].y)}, xg = (f32x4){bflo(ng[i].x), bfhi(ng[i].x), bflo(ng[i].y), bfhi(ng[i].y)};
                if (rr == 32 && lastc) { xv = (f32x4){0.f, 0.f, 0.f, 0.f}; xg = xv; }
                const f32x4 val = kv0 * pv + kv1 * cv + kv2 * xv + bv, gt = kg0 * pg + kg1 * cgt + kg2 * xg + bg;
                u32x2 w; w.x = cvt_pk_bf16(silu_f(gt[0]) * val[0], silu_f(gt[1]) * val[1]); w.y = cvt_pk_bf16(silu_f(gt[2]) * val[2], silu_f(gt[3]) * val[3]);
                *(u32x2*)(DST + (((size_t)(r0 + rr - 1) * DFF2 + ch) & dmask)) = w;
                pv = cv; pg = cgt; cv = xv; cgt = xg; }
        }
    }
}
__device__ __forceinline__ void ffngate_fix(bf16_t* A2, const bf16_t* side, int rows, const float* fk, const float* fb, int gw, int NGW, int lane) {
    const int ntask = (rows / 64) * 2 * 11;
    for (int wt = gw; wt < ntask; wt += NGW) {
        const int s = wt % 11, sw = wt / 11, last = sw & 1, G = sw >> 1, ch = 256 * s + 4 * lane;
        const int R = 64 * G + (last ? 63 : 0);
        const bool lat = R < ML; const int t = lat ? (R & (SEQ - 1)) : ((R - ML) & (CL - 1)); const int L = lat ? SEQ : CL;
        const bool hasp = t > 0, hasn = t < L - 1;
        const bf16_t* pc = side + (size_t)(G * 4 + (last ? 3 : 0)) * DFF2 + ch;
        const bf16_t* pp = last ? side + (size_t)(G * 4 + 2) * DFF2 + ch : side + (size_t)((G - 1) * 4 + 3) * DFF2 + ch;
        const bf16_t* pn = last ? side + (size_t)((G + 1) * 4 + 0) * DFF2 + ch : side + (size_t)(G * 4 + 1) * DFF2 + ch;
        u32x2 cv = *(const u32x2*)pc, cg = *(const u32x2*)(pc + DFF), pv = (u32x2){0u, 0u}, pg = pv, nv = pv, ng = pv;
        if (hasp) { pv = *(const u32x2*)pp; pg = *(const u32x2*)(pp + DFF); }
        if (hasn) { nv = *(const u32x2*)pn; ng = *(const u32x2*)(pn + DFF); }
        const f32x4 kv0 = *(const f32x4*)(fk + ch), kv1 = *(const f32x4*)(fk + DFF2 + ch), kv2 = *(const f32x4*)(fk + 2 * DFF2 + ch), bv = *(const f32x4*)(fb + ch);
        const f32x4 kg0 = *(const f32x4*)(fk + DFF + ch), kg1 = *(const f32x4*)(fk + DFF2 + DFF + ch), kg2 = *(const f32x4*)(fk + 2 * DFF2 + DFF + ch), bg = *(const f32x4*)(fb + DFF + ch);
#define UNP(w) (f32x4){bflo((w).x), bfhi((w).x), bflo((w).y), bfhi((w).y)}
        const f32x4 val = kv0 * UNP(pv) + kv1 * UNP(cv) + kv2 * UNP(nv) + bv, gt = kg0 * UNP(pg) + kg1 * UNP(cg) + kg2 * UNP(ng) + bg;
#undef UNP
        u32x2 w; w.x = cvt_pk_bf16(silu_f(gt[0]) * val[0], silu_f(gt[1]) * val[1]); w.y = cvt_pk_bf16(silu_f(gt[2]) * val[2], silu_f(gt[3]) * val[3]);
        *(u32x2*)(A2 + (size_t)R * DFF + ch) = w;
    }
}
__device__ __forceinline__ void attnprep_phase(bf16_t* QKV, const float* qg, const float* kg, int gw, int NGW, int lane) {
    for (int row = gw; row < MT; row += NGW) {
        const bool lat = row < ML; const int t = row & (SEQ - 1);
        const float pos = (lane & 2) ? (float)(t & 63) : (float)(t >> 6);
#pragma unroll
        for (int part = 0; part < 2; ++part) {
            const bool act = part == 0 || lane < 16;
            bf16_t* p = QKV + (size_t)row * 1536 + (part ? 1024 : 0) + (act ? lane * 16 : 0);
            const u32x4 r0 = *(const u32x4*)p, r1 = *(const u32x4*)(p + 8);
            float v[16];
#pragma unroll
            for (int e = 0; e < 4; ++e) { v[2 * e] = bflo(r0[e]); v[2 * e + 1] = bfhi(r0[e]); v[8 + 2 * e] = bflo(r1[e]); v[8 + 2 * e + 1] = bfhi(r1[e]); }
            float ss = 0.f;
#pragma unroll
            for (int e = 0; e < 16; ++e) ss += v[e] * v[e];
            ss += __shfl_xor(ss, 1); ss += __shfl_xor(ss, 2);
            const float rstd = 1.0f / sqrtf(ss * (1.f / 64.f) + EPS);
            const float* gp = (part ? kg : qg) + (lane & 3) * 16;
            const float osc = part ? 1.0f : C2;
            u32x4 o0, o1;
#pragma unroll
            for (int e = 0; e < 16; e += 2) {
                float y[2];
#pragma unroll
                for (int q = 0; q < 2; ++q) {
                    const float mine = v[e + q] * rstd * gp[e + q];
                    const float other = __shfl_xor(mine, 1);
                    float r = mine;
                    if (lat) {
                        const float ang = pos * __builtin_amdgcn_exp2f(-(float)(e + q) * (LOG2_THETA / 16.f));
                        float tr = ang * INV_2PI; tr -= rintf(tr);
                        const float sn = __builtin_amdgcn_sinf(tr), cs = __builtin_amdgcn_cosf(tr);
                        r = (lane & 1) ? (other * sn + mine * cs) : (mine * cs - other * sn);
                    }
                    y[q] = r * osc;
                }
                const unsigned w = cvt_pk_bf16(y[0], y[1]);
                if (e < 8) o0[e >> 1] = w; else o1[(e - 8) >> 1] = w;
            }
            if (act) { *(u32x4*)p = o0; *(u32x4*)(p + 8) = o1; }
        }
    }
}
__device__ __forceinline__ void retprep_phase(bf16_t* R, bf16_t* RC, int gw, int NGW, int lane) {
    for (int row = gw; row < MT; row += NGW) {
        const bool lat = row < ML;
        if (lat) {
            const int t = row & (SEQ - 1);
            const float pos = (lane & 8) ? (float)(t & 63) : (float)(t >> 6);
#pragma unroll
            for (int part = 0; part < 2; ++part) {
                bf16_t* p = R + (size_t)row * 6144 + part * 1024 + lane * 16;
                const u32x4 r0 = *(const u32x4*)p, r1 = *(const u32x4*)(p + 8);
                float v[16];
#pragma unroll
                for (int e = 0; e < 4; ++e) { v[2 * e] = bflo(r0[e]); v[2 * e + 1] = bfhi(r0[e]); v[8 + 2 * e] = bflo(r1[e]); v[8 + 2 * e + 1] = bfhi(r1[e]); }
                const float osc = part ? 0.0625f : 1.0f;
                u32x4 o0, o1;
#pragma unroll
                for (int e = 0; e < 16; e += 2) {
                    float y[2];
#pragma unroll
                    for (int q = 0; q < 2; ++q) {
                        const float mine = v[e + q];
                        const float other = __shfl_xor(mine, 4);
                        const float ang = pos * __builtin_amdgcn_exp2f(-(float)((lane & 3) * 16 + e + q) * (LOG2_THETA / 64.f));
                        float tr = ang * INV_2PI; tr -= rintf(tr);
                        const float sn = __builtin_amdgcn_sinf(tr), cs = __builtin_amdgcn_cosf(tr);
                        y[q] = ((lane & 4) ? (other * sn + mine * cs) : (mine * cs - other * sn)) * osc;
                    }
                    const unsigned w = cvt_pk_bf16(y[0], y[1]);
                    if (e < 8) o0[e >> 1] = w; else o1[(e - 8) >> 1] = w;
                }
                *(u32x4*)p = o0; *(u32x4*)(p + 8) = o1;
            }
        } else {
            bf16_t* p = RC + (size_t)(row - ML) * 3072 + lane * 16;
            const u32x4 r0 = *(const u32x4*)p, r1 = *(const u32x4*)(p + 8);
            u32x4 o0, o1;
#pragma unroll
            for (int e = 0; e < 4; ++e) { o0[e] = cvt_pk_bf16(bflo(r0[e]) * 0.0625f, bfhi(r0[e]) * 0.0625f); o1[e] = cvt_pk_bf16(bflo(r1[e]) * 0.0625f, bfhi(r1[e]) * 0.0625f); }
            *(u32x4*)p = o0; *(u32x4*)(p + 8) = o1;
        }
    }
}

namespace attn_body {
using bf16=__hip_bfloat16;
using bf16x8=__attribute__((ext_vector_type(8)))short;
using s16x4=__attribute__((ext_vector_type(4)))short;
using f32x16=__attribute__((ext_vector_type(16)))float;
using u32x4=__attribute__((ext_vector_type(4)))unsigned;
constexpr int D=64,QP=1536,OP=1024;
constexpr int NW=8,QBLK=32,QB=QBLK*NW,KVBLK=64;
__device__ __forceinline__ int crow(int r,int hi){return (r&3)+8*(r>>2)+4*hi;}
#define SBAR() __builtin_amdgcn_sched_barrier(0)
constexpr int NSLOT=3, SLOTB=8192;
constexpr int LDS_K=0, LDS_V=NSLOT*SLOTB, LDS_WS=2*NSLOT*SLOTB, LDS_OST=LDS_WS+NW*64*4, LDS_BYTES=LDS_OST+NW*4096;
constexpr float C2=0.125f*1.4426950408889634f;
__device__ __forceinline__ void glds16(const void*gsrc,unsigned lds_dst){unsigned keep;
  asm volatile("s_mov_b32 %0, m0\n\ts_mov_b32 m0, %2\n\ts_nop 0\n\tglobal_load_lds_dwordx4 %1, off\n\ts_mov_b32 m0, %0":"=&s"(keep):"v"(gsrc),"s"(lds_dst):"memory");}
__device__ __forceinline__ float max3f(float a,float b,float c){float r;asm("v_max3_f32 %0, %1, %2, %3":"=v"(r):"v"(a),"v"(b),"v"(c));return r;}
__device__ __forceinline__ float max2f(float a,float b){float r;asm("v_max_f32_e32 %0, %1, %2":"=v"(r):"v"(a),"v"(b));return r;}
__device__ __forceinline__ float fadd_s(float a,float b){float r;asm("v_add_f32_e32 %0, %1, %2":"=v"(r):"v"(a),"v"(b));return r;}
__device__ __forceinline__ float fsub_s(float a,float b){float r;asm("v_sub_f32_e32 %0, %1, %2":"=v"(r):"v"(a),"v"(b));return r;}
typedef float f32x2_t __attribute__((ext_vector_type(2))); typedef __bf16 bf16x2_t __attribute__((ext_vector_type(2)));
__device__ __forceinline__ unsigned cvtpk_s(float lo,float hi){f32x2_t v={lo,hi};bf16x2_t b=__builtin_convertvector(v,bf16x2_t);return __builtin_bit_cast(unsigned,b);}
#define WAIT_BAR(N) asm volatile("s_waitcnt vmcnt(" #N ") lgkmcnt(0)\n\ts_barrier":::"memory")

__device__ __forceinline__ void qkt(f32x16&p0,f32x16&p1,const char*Kslot,const bf16x8*qr,const f32x16&negm,int r32,int hi){
  const char*kb=Kslot+hi*1024+r32*16;
  #pragma unroll
  for(int d0=0;d0<4;++d0){
    const bf16x8 b0=*reinterpret_cast<const bf16x8*>(kb+d0*2048);
    const bf16x8 b1=*reinterpret_cast<const bf16x8*>(kb+d0*2048+512);
    if(d0==0){p0=__builtin_amdgcn_mfma_f32_32x32x16_bf16(b0,qr[0],negm,0,0,0);p1=__builtin_amdgcn_mfma_f32_32x32x16_bf16(b1,qr[0],negm,0,0,0);}
    else{p0=__builtin_amdgcn_mfma_f32_32x32x16_bf16(b0,qr[d0],p0,0,0,0);p1=__builtin_amdgcn_mfma_f32_32x32x16_bf16(b1,qr[d0],p1,0,0,0);}}
}
typedef __attribute__((address_space(3))) const char* lds_cptr;
typedef short v4i16_t __attribute__((ext_vector_type(4)));
__device__ __forceinline__ void kload8(bf16x8*kf,lds_cptr kp){
  kf[0]=*(const __attribute__((address_space(3))) bf16x8*)(kp);      kf[1]=*(const __attribute__((address_space(3))) bf16x8*)(kp+512);
  kf[2]=*(const __attribute__((address_space(3))) bf16x8*)(kp+2048); kf[3]=*(const __attribute__((address_space(3))) bf16x8*)(kp+2560);
  kf[4]=*(const __attribute__((address_space(3))) bf16x8*)(kp+4096); kf[5]=*(const __attribute__((address_space(3))) bf16x8*)(kp+4608);
  kf[6]=*(const __attribute__((address_space(3))) bf16x8*)(kp+6144); kf[7]=*(const __attribute__((address_space(3))) bf16x8*)(kp+6656);
}
__device__ __forceinline__ void kload2(bf16x8*kf,lds_cptr kp,int j){ kf[2*j]=*(const __attribute__((address_space(3))) bf16x8*)(kp+j*2048); kf[2*j+1]=*(const __attribute__((address_space(3))) bf16x8*)(kp+j*2048+512); }
__device__ __forceinline__ s16x4 vtr(lds_cptr p){ return __builtin_bit_cast(s16x4,__builtin_amdgcn_ds_read_tr16_b64_v4i16((__attribute__((address_space(3))) v4i16_t*)p)); }
__device__ __forceinline__ float rowmax(const f32x16&p0,const f32x16&p1){
  float a=max3f(p0[0],p0[1],p1[0]),b=max3f(p0[2],p0[3],p1[1]);a=max3f(a,p1[2],p1[3]);
  #pragma unroll
  for(int r=4;r<16;r+=4){a=max3f(a,p0[r],p0[r+1]);b=max3f(b,p0[r+2],p0[r+3]);a=max3f(a,p1[r],p1[r+1]);b=max3f(b,p1[r+2],p1[r+3]);}
  const float m=max2f(a,b);
  auto rr=__builtin_amdgcn_permlane32_swap(__float_as_uint(m),__float_as_uint(m),false,false);
  return max2f(__uint_as_float(rr[0]),__uint_as_float(rr[1]));
}
__device__ __forceinline__ void pv(f32x16*o,int vb,bf16x8 pa0,bf16x8 pa1,bf16x8 pa2,bf16x8 pa3){
  #pragma unroll
  for(int d0=0;d0<2;++d0){s16x4 lo[4],hi[4];
    #pragma unroll
    for(int ks=0;ks<4;++ks){
      asm volatile("ds_read_b64_tr_b16 %0,%1 offset:%c2":"=&v"(lo[ks]):"v"(vb),"i"(d0*4096+ks*1024):"memory");
      asm volatile("ds_read_b64_tr_b16 %0,%1 offset:%c2":"=&v"(hi[ks]):"v"(vb),"i"(d0*4096+ks*1024+512):"memory");}
    asm volatile("s_waitcnt lgkmcnt(0)":::"memory");SBAR();
    #define PK(k) (bf16x8){lo[k][0],lo[k][1],lo[k][2],lo[k][3],hi[k][0],hi[k][1],hi[k][2],hi[k][3]}
    o[d0]=__builtin_amdgcn_mfma_f32_32x32x16_bf16(pa0,PK(0),o[d0],0,0,0);
    o[d0]=__builtin_amdgcn_mfma_f32_32x32x16_bf16(pa1,PK(1),o[d0],0,0,0);
    o[d0]=__builtin_amdgcn_mfma_f32_32x32x16_bf16(pa2,PK(2),o[d0],0,0,0);
    o[d0]=__builtin_amdgcn_mfma_f32_32x32x16_bf16(pa3,PK(3),o[d0],0,0,0);
    #undef PK
  }
}

#ifndef ATTN_STORE16
#define ATTN_STORE16(p,v) (*(u32x4*)(p)=(v))
#endif
template<int THRL> __device__ __forceinline__ void attn_unit(const bf16*Qw0,const bf16*__restrict__ Kcol,int latrow0,int nlat,int ctxrow0,int NT,bf16*Ow0,char*shm,const int tid){
  const int lane=tid&63,r32=lane&31,hi=lane>>5; const int wid=__builtin_amdgcn_readfirstlane(tid>>6);
  const bf16*Qw=Qw0+(long)(wid*QBLK)*QP;
  const unsigned lds0=(unsigned)(uintptr_t)shm;
  float*wsf=(float*)(shm+LDS_WS)+wid*64;
  const bf16*ksrc=Kcol+(long)lane*QP+wid*8;
  const bf16*vsrc=Kcol+256+(long)(16*(wid&3)+(lane>>2))*QP+(wid>>2)*32+(lane&3)*8;
  #define TROW(t) ((long)(((t)<nlat)?latrow0+64*(t):ctxrow0+64*((t)-nlat))*QP)
  const unsigned kdst=lds0+LDS_K+wid*1024, vdst=lds0+LDS_V+wid*1024;
  #define DMA_K(t,slot) glds16(ksrc+TROW(t),(unsigned)__builtin_amdgcn_readfirstlane(kdst+(slot)))
  #define DMA_V(t,slot) glds16(vsrc+TROW(t),(unsigned)__builtin_amdgcn_readfirstlane(vdst+(slot)))
  const int vb0=(int)(lds0+LDS_V)+((lane>>4)&1)*32+(lane&3)*8+(4*hi+((lane&15)>>2))*64;
  const char*Kbase=shm+LDS_K; bf16x8 kf[8];
  const lds_cptr shm3=(lds_cptr)shm; const lds_cptr kp0=shm3+LDS_K+hi*1024+r32*16; const lds_cptr vp0=shm3+LDS_V+((lane>>4)&1)*32+(lane&3)*8+(4*hi+((lane&15)>>2))*64;
  DMA_K(0,0);DMA_V(0,0);DMA_K(1,SLOTB);
  bf16x8 qr[4];
  #pragma unroll
  for(int d0=0;d0<4;++d0)qr[d0]=*reinterpret_cast<const bf16x8*>(&Qw[(long)r32*QP+d0*16+hi*8]);
  float mhat=0.f,l_reg=0.f;f32x16 o[2];o[0]=f32x16{};o[1]=f32x16{};const f32x16 negm=f32x16{};
  #define CMASK(P0,P1,t) do{}while(0)
  bool resc=false;
  #define START(P0,P1) do{ const float rm=rowmax(P0,P1); resc=false; \
    { const float dl=rm; mhat=fadd_s(mhat,dl); \
      _Pragma("unroll") for(int r=0;r<16;++r){P0[r]=fsub_s(P0[r],dl);P1[r]=fsub_s(P1[r],dl);} } \
    _Pragma("unroll") for(int r=0;r<16;++r)P0[r]=__builtin_amdgcn_exp2f(P0[r]); }while(0)
  #define RESC() do{ if(resc){ asm volatile("s_waitcnt lgkmcnt(0)":::"memory"); \
      _Pragma("unroll") for(int d_=0;d_<2;++d_) _Pragma("unroll") for(int r=0;r<16;++r)o[d_][r]*=wsf[crow(r,hi)]; } }while(0)
  f32x16 pA0,pA1,pB0,pB1;
  int sl_prev=0,sl_cur=0,sl_next=SLOTB;
  #define ROT() do{sl_prev=sl_cur;sl_cur=sl_next;sl_next=(sl_next==(NSLOT-1)*SLOTB)?0:sl_next+SLOTB;}while(0)
  DMA_K(2,2*SLOTB);
  WAIT_BAR(3);
  qkt(pA0,pA1,Kbase,qr,negm,r32,hi);asm volatile("s_nop 15\n\ts_nop 7":"+v"(pA0),"+v"(pA1));CMASK(pA0,pA1,0);
  START(pA0,pA1);
  _Pragma("unroll") for(int r=0;r<16;++r)pA1[r]=__builtin_amdgcn_exp2f(pA1[r]);
  WAIT_BAR(0);
  DMA_K(3,0);DMA_V(1,SLOTB);
  ROT();
  kload8(kf,kp0+sl_cur);
  WAIT_BAR(2);
  s16x4 vlo[8],vhi[8]; u32x4 pw0,pw1,pw2,pw3;
  #define PKW(P,B) cvtpk_s(P[B],P[B+1])
  #define PAF(k) __builtin_bit_cast(bf16x8,pw##k)
  #define VFR(i) (bf16x8){vlo[i][0],vlo[i][1],vlo[i][2],vlo[i][3],vhi[i][0],vhi[i][1],vhi[i][2],vhi[i][3]}
  #define PIN(x) asm volatile("":"+v"(x))
  #define MX3(a,b,c) __builtin_fmaxf(__builtin_fmaxf((a),(b)),(c))
  #define GAPA(MF,A0,A1,A2,A3,W0,W1,PW) do{ MF; sacc+=A0; sacc+=A1; sacc+=A2; sacc+=A3; PIN(sacc); W0; W1; PIN(PW); SBAR(); }while(0)
  #define EX(v) __builtin_amdgcn_exp2f(v)
  #define GAPB(MF,X,B) do{ MF; X[B]=EX(X[B]); X[B+1]=EX(X[B+1]); X[B+2]=EX(X[B+2]); X[B+3]=EX(X[B+3]); PIN(X); SBAR(); }while(0)
  #define VRD(i) do{ vlo[i]=vtr(vp_+(((i)>>2)*4096+((i)&3)*1024)); vhi[i]=vtr(vp_+(((i)>>2)*4096+((i)&3)*1024+512)); }while(0)
  #define KRD(G,j) do{ if(G){ kload2(kf,kp0+sl_next,j); SBAR(); } }while(0)
  #define STEP(C0,C1,P0,P1,t,GK,GV,GL) do{ SBAR(); \
    const lds_cptr vp_=vp0+sl_prev; \
    VRD(0); SBAR(); float sacc=(P0[0]+P0[1]); \
    GAPA(C0=__builtin_amdgcn_mfma_f32_32x32x16_bf16(kf[0],qr[0],negm,0,0,0), P0[2],P0[3],P0[4],P0[5],     pw0[0]=PKW(P0,0), pw0[1]=PKW(P0,2), pw0); \
    VRD(4); SBAR(); GAPA(C1=__builtin_amdgcn_mfma_f32_32x32x16_bf16(kf[1],qr[0],negm,0,0,0), P0[6],P0[7],P0[8],P0[9],     pw0[2]=PKW(P0,4), pw0[3]=PKW(P0,6), pw0); \
    VRD(1); SBAR(); GAPA(C0=__builtin_amdgcn_mfma_f32_32x32x16_bf16(kf[2],qr[1],C0,0,0,0),   P0[10],P0[11],P0[12],P0[13], pw1[0]=PKW(P0,8), pw1[1]=PKW(P0,10), pw1); \
    VRD(5); SBAR(); GAPA(C1=__builtin_amdgcn_mfma_f32_32x32x16_bf16(kf[3],qr[1],C1,0,0,0),   P0[14],P0[15],P1[0],P1[1],   pw1[2]=PKW(P0,12),pw1[3]=PKW(P0,14), pw1); \
    VRD(2); SBAR(); GAPA(C0=__builtin_amdgcn_mfma_f32_32x32x16_bf16(kf[4],qr[2],C0,0,0,0),   P1[2],P1[3],P1[4],P1[5],     pw2[0]=PKW(P1,0), pw2[1]=PKW(P1,2), pw2); \
    VRD(6); SBAR(); GAPA(C1=__builtin_amdgcn_mfma_f32_32x32x16_bf16(kf[5],qr[2],C1,0,0,0),   P1[6],P1[7],P1[8],P1[9],     pw2[2]=PKW(P1,4), pw2[3]=PKW(P1,6), pw2); \
    VRD(3); SBAR(); GAPA(C0=__builtin_amdgcn_mfma_f32_32x32x16_bf16(kf[6],qr[3],C0,0,0,0),   P1[10],P1[11],P1[12],P1[13], pw3[0]=PKW(P1,8), pw3[1]=PKW(P1,10), pw3); \
    VRD(7); SBAR(); GAPA(C1=__builtin_amdgcn_mfma_f32_32x32x16_bf16(kf[7],qr[3],C1,0,0,0),   P1[14],P1[15],0.f,0.f,       pw3[2]=PKW(P1,12),pw3[3]=PKW(P1,14), pw3); \
    l_reg+=sacc; \
    if(GK){DMA_K((t)+3,sl_cur);} if(GV){DMA_V((t)+1,sl_next);} \
    _Pragma("unroll") for(int r=0;r<16;++r){C0[r]-=mhat;C1[r]-=mhat;} \
    { float a=MX3(C0[0],C0[1],C1[0]),b=MX3(C0[2],C0[3],C1[1]); a=MX3(a,C1[2],C1[3]); \
      _Pragma("unroll") for(int r=4;r<16;r+=4){a=MX3(a,C0[r],C0[r+1]);b=MX3(b,C0[r+2],C0[r+3]);a=MX3(a,C1[r],C1[r+1]);b=MX3(b,C1[r+2],C1[r+3]);} \
      float rm=__builtin_fmaxf(a,b); { auto rr=__builtin_amdgcn_permlane32_swap(__float_as_uint(rm),__float_as_uint(rm),false,false); rm=__builtin_fmaxf(__uint_as_float(rr[0]),__uint_as_float(rr[1])); } \
      resc=false; \
      if(__builtin_expect(__any(rm>(float)THRL),0)){ const float dl=__builtin_fmaxf(rm,0.f); mhat+=dl; \
        _Pragma("unroll") for(int r=0;r<16;++r){C0[r]-=dl;C1[r]-=dl;} \
        const float f=__builtin_amdgcn_exp2f(-dl); l_reg*=f; if(hi==0)wsf[r32]=f; resc=true; } } \
    SBAR(); \
    GAPB(o[0]=__builtin_amdgcn_mfma_f32_32x32x16_bf16(PAF(0),VFR(0),o[0],0,0,0), C0,0); \
    GAPB(o[1]=__builtin_amdgcn_mfma_f32_32x32x16_bf16(PAF(0),VFR(4),o[1],0,0,0), C0,4); \
    KRD(GL,0); GAPB(o[0]=__builtin_amdgcn_mfma_f32_32x32x16_bf16(PAF(1),VFR(1),o[0],0,0,0), C0,8); \
    KRD(GL,1); GAPB(o[1]=__builtin_amdgcn_mfma_f32_32x32x16_bf16(PAF(1),VFR(5),o[1],0,0,0), C0,12); \
    KRD(GL,2); GAPB(o[0]=__builtin_amdgcn_mfma_f32_32x32x16_bf16(PAF(2),VFR(2),o[0],0,0,0), C1,0); \
    KRD(GL,3); GAPB(o[1]=__builtin_amdgcn_mfma_f32_32x32x16_bf16(PAF(2),VFR(6),o[1],0,0,0), C1,4); \
    GAPB(o[0]=__builtin_amdgcn_mfma_f32_32x32x16_bf16(PAF(3),VFR(3),o[0],0,0,0), C1,8); \
    GAPB(o[1]=__builtin_amdgcn_mfma_f32_32x32x16_bf16(PAF(3),VFR(7),o[1],0,0,0), C1,12); \
    }while(0)
  int t=1;
  for(;t+5<NT;t+=2){
    STEP(pB0,pB1,pA0,pA1,t,true,true,true);     WAIT_BAR(2); RESC(); ROT();
    STEP(pA0,pA1,pB0,pB1,t+1,true,true,true);   WAIT_BAR(2); RESC(); ROT();
  }
  #define ENDW(tt) do{ if((tt)+3<NT){WAIT_BAR(2);} else if((tt)+2<NT){WAIT_BAR(1);} else {WAIT_BAR(0);} }while(0)
  for(;t+1<NT;t+=2){
    STEP(pB0,pB1,pA0,pA1,t,(t+3<NT),(t+1<NT),(t+1<NT));       ENDW(t);   RESC(); ROT();
    STEP(pA0,pA1,pB0,pB1,t+1,(t+4<NT),(t+2<NT),(t+2<NT));     ENDW(t+1); RESC(); ROT();
  }
  STEP(pB0,pB1,pA0,pA1,NT-1,false,false,false); RESC();
  { float sacc=pB0[0]+pB0[1]; _Pragma("unroll") for(int r=2;r<16;++r)sacc+=pB0[r]; _Pragma("unroll") for(int r=0;r<16;++r)sacc+=pB1[r]; l_reg+=sacc;
    pw0=(u32x4){PKW(pB0,0),PKW(pB0,2),PKW(pB0,4),PKW(pB0,6)};pw1=(u32x4){PKW(pB0,8),PKW(pB0,10),PKW(pB0,12),PKW(pB0,14)};pw2=(u32x4){PKW(pB1,0),PKW(pB1,2),PKW(pB1,4),PKW(pB1,6)};pw3=(u32x4){PKW(pB1,8),PKW(pB1,10),PKW(pB1,12),PKW(pB1,14)};
    SBAR(); pv(o,vb0+sl_cur,PAF(0),PAF(1),PAF(2),PAF(3)); }
  #undef PKW
  #undef PAF
  #undef VFR
  #undef PIN
  #undef MX3
  #undef GAPA
  #undef GAPB
  #undef EX
  #undef VRD
  #undef KRD
  #undef STEP
  #undef ENDW
  {auto rr=__builtin_amdgcn_permlane32_swap(__float_as_uint(l_reg),__float_as_uint(l_reg),false,false);l_reg=__uint_as_float(rr[0])+__uint_as_float(rr[1]);}
  if(hi==0)wsf[32+r32]=l_reg;asm volatile("s_waitcnt lgkmcnt(0)":::"memory");
  float rli[16];
  #pragma unroll
  for(int r=0;r<16;++r)rli[r]=__builtin_amdgcn_rcpf(wsf[32+crow(r,hi)]);
  bf16*Ow=Ow0+(long)(wid*QBLK)*OP;
  { bf16*stg=(bf16*)(shm+LDS_OST)+wid*2048;
    #pragma unroll
    for(int r=0;r<16;++r){const int orow=crow(r,hi);
      #pragma unroll
      for(int d0=0;d0<2;++d0)stg[orow*64+d0*32+r32]=__float2bfloat16(o[d0][r]*rli[r]);}
    asm volatile("s_waitcnt lgkmcnt(0)":::"memory");
    #pragma unroll
    for(int i=0;i<4;++i){const int row=i*8+(lane>>3),ch=lane&7; const u32x4 v=*(const u32x4*)(stg+row*64+ch*8); ATTN_STORE16(Ow+(long)row*OP+ch*8,v);} }
  asm volatile("s_waitcnt lgkmcnt(0)\n\ts_barrier":::"memory");
  #undef DMA_K
  #undef TROW
  #undef DMA_V
  #undef CMASK
  #undef START
  #undef RESC
  #undef ROT
}
constexpr int ATTN_LDS_BYTES=LDS_BYTES;
#undef SBAR
#undef WAIT_BAR
}
__device__ __forceinline__ void attn_unit_simple(ldsp lds, const bf16_t* QKV, bf16_t* O, int qrow0, int h, int latbase, int nlat_tiles, int ctxbase, int NT, const int tid) {
    const int lane = tid & 63, wid = __builtin_amdgcn_readfirstlane(tid >> 6), l15 = lane & 15, lg = lane >> 4;
    const int kvh = h >> 2;
    const ldsp Kb = lds, Vb = lds + 18432, Pw = lds + 36864 + wid * 4608;
    bf16x8 qf[2][2];
#pragma unroll
    for (int qb = 0; qb < 2; ++qb)
#pragma unroll
        for (int ks = 0; ks < 2; ++ks) qf[qb][ks] = *(const bf16x8*)(QKV + (size_t)(qrow0 + 32 * wid + 16 * qb + l15) * 1536 + h * 64 + 32 * ks + 8 * lg);
    const int lrow = tid >> 3, lch = tid & 7;
    u32x4 kr, vr;
    { const int r = ((0 < nlat_tiles) ? latbase : ctxbase) + lrow; const bf16_t* p = QKV + (size_t)r * 1536 + 1024 + kvh * 64 + lch * 8; kr = *(const u32x4*)p; vr = *(const u32x4*)(p + 256); }
    *(LAS u32x4*)(Kb + lrow * 144 + lch * 16) = kr; *(LAS u32x4*)(Vb + lrow * 144 + lch * 16) = vr;
    __syncthreads();
    f32x4 o[4][2];
#pragma unroll
    for (int db = 0; db < 4; ++db) { o[db][0] = (f32x4){0.f, 0.f, 0.f, 0.f}; o[db][1] = o[db][0]; }
    float mrun[2] = {-INFINITY, -INFINITY}, lsum[2] = {0.f, 0.f};
    for (int t = 0; t < NT; ++t) {
        const int cur = t & 1;
        if (t + 1 < NT) { const int tn = t + 1; const int r = ((tn < nlat_tiles) ? latbase + 64 * tn : ctxbase + 64 * (tn - nlat_tiles)) + lrow;
            const bf16_t* p = QKV + (size_t)r * 1536 + 1024 + kvh * 64 + lch * 8; kr = *(const u32x4*)p; vr = *(const u32x4*)(p + 256); }
        f32x4 s[4][2];
#pragma unroll
        for (int kb = 0; kb < 4; ++kb) {
            const ldsp kp = Kb + cur * 9216 + (16 * kb + l15) * 144 + lg * 16;
            const bf16x8 k0 = *(const LAS bf16x8*)kp, k1 = *(const LAS bf16x8*)(kp + 64);
#pragma unroll
            for (int qb = 0; qb < 2; ++qb) { s[kb][qb] = mfma16(k0, qf[qb][0], (f32x4){0.f, 0.f, 0.f, 0.f}); s[kb][qb] = mfma16(k1, qf[qb][1], s[kb][qb]); }
        }
#pragma unroll
        for (int qb = 0; qb < 2; ++qb) {
            float mx = s[0][qb][0];
#pragma unroll
            for (int kb = 0; kb < 4; ++kb)
#pragma unroll
                for (int j = 0; j < 4; ++j) mx = fmaxf(mx, s[kb][qb][j]);
            mx = fmaxf(mx, __shfl_xor(mx, 16)); mx = fmaxf(mx, __shfl_xor(mx, 32));
            const float mn = fmaxf(mrun[qb], mx), al = __builtin_amdgcn_exp2f(mrun[qb] - mn); mrun[qb] = mn;
            float ps = 0.f;
#pragma unroll
            for (int kb = 0; kb < 4; ++kb) {
                float p[4];
#pragma unroll
                for (int j = 0; j < 4; ++j) { p[j] = __builtin_amdgcn_exp2f(s[kb][qb][j] - mn); ps += p[j]; }
                u32x2 w; w.x = cvt_pk_bf16(p[0], p[1]); w.y = cvt_pk_bf16(p[2], p[3]);
                *(LAS u32x2*)(Pw + (16 * qb + l15) * 144 + (16 * kb + 4 * lg) * 2) = w;
            }
            lsum[qb] = lsum[qb] * al + ps;
#pragma unroll
            for (int db = 0; db < 4; ++db) o[db][qb] *= al;
        }
#pragma unroll
        for (int ks = 0; ks < 2; ++ks) {
            bf16x8 pf[2];
#pragma unroll
            for (int qb = 0; qb < 2; ++qb) pf[qb] = *(const LAS bf16x8*)(Pw + (16 * qb + l15) * 144 + (32 * ks + 8 * lg) * 2);
#pragma unroll
            for (int db = 0; db < 4; ++db) {
                const ldsp vp = Vb + cur * 9216 + (32 * ks + 8 * lg + (l15 >> 2)) * 144 + (16 * db + 4 * (l15 & 3)) * 2;
                const s16x4 lo = lds_tr(vp), hi = lds_tr(vp + 4 * 144);
                const bf16x8 vf = (bf16x8){lo[0], lo[1], lo[2], lo[3], hi[0], hi[1], hi[2], hi[3]};
#pragma unroll
                for (int qb = 0; qb < 2; ++qb) o[db][qb] = mfma16(vf, pf[qb], o[db][qb]);
            }
        }
        if (t + 1 < NT) { *(LAS u32x4*)(Kb + (cur ^ 1) * 9216 + lrow * 144 + lch * 16) = kr; *(LAS u32x4*)(Vb + (cur ^ 1) * 9216 + lrow * 144 + lch * 16) = vr; }
        __syncthreads();
    }
#pragma unroll
    for (int qb = 0; qb < 2; ++qb) {
        float l = lsum[qb]; l += __shfl_xor(l, 16); l += __shfl_xor(l, 32);
        const float inv = 1.0f / l;
        bf16_t* op = O + (size_t)(qrow0 + 32 * wid + 16 * qb + l15) * D + h * 64 + 4 * lg;
#pragma unroll
        for (int db = 0; db < 4; ++db) { u32x2 w; w.x = cvt_pk_bf16(o[db][qb][0] * inv, o[db][qb][1] * inv); w.y = cvt_pk_bf16(o[db][qb][2] * inv, o[db][qb][3] * inv);
            *(u32x2*)(op + 16 * db) = w; }
    }
}
#ifndef ATT_SIMPLE
#define ATT_SIMPLE 0
#endif
__device__ __forceinline__ void attn_phase(ldsp lds, char* shm, const bf16_t* QKV, bf16_t* O, const int tid, const int bx) {
    const int xcd = bx & 7, slot = bx >> 3;
    typedef attn_body::bf16 abf;
    for (int i = 0; i < 4; ++i) {
        const int bk = 8 * i + xcd, b = bk >> 2, kvh = bk & 3, h = kvh * 4 + (slot >> 3), qb = slot & 7;
#if ATT_SIMPLE
        attn_unit_simple(lds, QKV, O, b * SEQ + qb * 256, h, b * SEQ, 32, ML + b * CL, 36, tid);
#else
        attn_body::attn_unit<8>((const abf*)(QKV + (size_t)(b * SEQ + qb * 256) * 1536 + h * 64), (const abf*)(QKV + 1024 + kvh * 64), b * SEQ, 32, ML + b * CL, 36,
                                (abf*)(O + (size_t)(b * SEQ + qb * 256) * D + h * 64), shm, tid);
#endif
    }
    if (slot < 16) { const int b = xcd, h = slot;
#if ATT_SIMPLE
        attn_unit_simple(lds, QKV, O, ML + b * CL, h, 0, 0, ML + b * CL, 4, tid);
#else
        attn_body::attn_unit<8>((const abf*)(QKV + (size_t)(ML + b * CL) * 1536 + h * 64), (const abf*)(QKV + 1024 + (h >> 2) * 64), 0, 0, ML + b * CL, 4,
                                (abf*)(O + (size_t)(ML + b * CL) * D + h * 64), shm, tid);
#endif
    }
}

__device__ __forceinline__ void ret_unit(ldsp lds, bf16_t* R, const bf16_t* RC, int b, int h, int qblk, float lgf2, float lgb2, const int tid_in) {
    int tl0_ = tid_in; asm volatile("" : "+v"(tl0_));
    const int tid_outer = tl0_;
    const int wid = __builtin_amdgcn_readfirstlane(tid_outer >> 6);
    const ldsp Ks = lds, Vs = lds + 67584, Ps = lds + 134144;
    const int q0 = qblk * 64, rowq0 = b * SEQ + q0;
    const int qb = wid & 3, kbp = wid >> 2;
    bf16x8 qf[8];
    { const int l15 = tid_outer & 15, lg = (tid_outer & 63) >> 4;
#pragma unroll
      for (int ks = 0; ks < 8; ++ks) qf[ks] = *(const bf16x8*)(R + (size_t)(rowq0 + 16 * qb + l15) * 6144 + h * 256 + 32 * ks + 8 * lg); }
    u32x4 vr[8];
#define RET_BAR() do { asm volatile("s_waitcnt lgkmcnt(0)" ::: "memory"); __builtin_amdgcn_s_barrier(); asm volatile("" ::: "memory"); } while (0)
#define RET_KV(t) const char* kb_; unsigned kp_; \
        if ((t) < 32) { kb_ = (const char*)(R + (size_t)(b * SEQ + 64 * (t)) * 6144 + 1024 + h * 256); kp_ = 6144u * 2u; } \
        else { kb_ = (const char*)(RC + (size_t)(b * CL + 64 * ((t) - 32)) * 3072 + h * 256); kp_ = 3072u * 2u; }
#define RET_DMAK(t, buf) do { RET_KV(t) const int hf_ = lane >> 5; \
        _Pragma("unroll") for (int i_ = 0; i_ < 4; ++i_) { const int pp_ = 4 * wid + i_; const int row_ = 16 * (pp_ >> 3) + (pp_ & 7) + 8 * hf_; \
            attn_body::glds16(kb_ + (size_t)row_ * kp_ + (unsigned)(((lane & 31) ^ hf_) * 16), (unsigned)__builtin_amdgcn_readfirstlane((int)(unsigned)(size_t)(Ks + (buf) * 33792 + pp_ * 1056))); } } while (0)
#define RET_LOADV(t) do { RET_KV(t) const char* vb_ = kb_ + (1024 + h * 256) * 2; const unsigned lo_ = (unsigned)(tid >> 6) * kp_ + (unsigned)(tid & 63) * 16u; \
        _Pragma("unroll") for (int i_ = 0; i_ < 8; ++i_) vr[i_] = *(const u32x4*)(vb_ + (size_t)(8u * i_) * kp_ + lo_); } while (0)
#define RET_STOREV() do { _Pragma("unroll") for (int i_ = 0; i_ < 8; ++i_) *(LAS u32x4*)(Vs + ((tid >> 6) + 8 * i_) * 1040 + (tid & 63) * 16) = vr[i_]; } while (0)
#define RET_S(t) do { const ldsp pbuf_ = Ps + ((t) & 1) * 9216; \
        const ldsp krd_ = Ks + ((t) & 1) * 33792 + (l15 & 7) * 1056 + (l15 >> 3) * 512; const int hx_ = l15 >> 3; \
        f32x4 s_[2]; s_[0] = (f32x4){0.f, 0.f, 0.f, 0.f}; s_[1] = s_[0]; \
        _Pragma("unroll") for (int ks = 0; ks < 8; ++ks) { _Pragma("unroll") for (int kk = 0; kk < 2; ++kk) { \
            const bf16x8 kf_ = *(const LAS bf16x8*)(krd_ + (2 * kbp + kk) * 8 * 1056 + (((4 * ks + lg) ^ hx_) * 16)); s_[kk] = mfma16(kf_, qf[ks], s_[kk]); } } \
        const int p_ = q0 + 16 * qb + l15; \
        _Pragma("unroll") for (int kk = 0; kk < 2; ++kk) { float pv_[4]; \
            _Pragma("unroll") for (int j = 0; j < 4; ++j) { const int key_ = 16 * (2 * kbp + kk) + 4 * lg + j; float w_; \
                if ((t) < 32) { const int d_ = p_ - (64 * (t) + key_); w_ = (d_ >= 0) ? __builtin_amdgcn_exp2f(lgf2 * (float)d_) : __builtin_amdgcn_exp2f(lgb2 * (float)(-d_)); } \
                else { const int jj_ = 64 * ((t) - 32) + key_; w_ = __builtin_amdgcn_exp2f(lgf2 * (float)(p_ + CL - jj_)) + __builtin_amdgcn_exp2f(lgb2 * (float)(SEQ - p_ + jj_)); } \
                pv_[j] = s_[kk][j] * w_; } \
            u32x2 w2_; w2_.x = cvt_pk_bf16(pv_[0], pv_[1]); w2_.y = cvt_pk_bf16(pv_[2], pv_[3]); \
            *(LAS u32x2*)(pbuf_ + (16 * qb + l15) * 144 + (16 * (2 * kbp + kk) + 4 * lg) * 2) = w2_; } } while (0)
#define RET_PV(t) do { const ldsp pbuf_ = Ps + ((t) & 1) * 9216; \
        _Pragma("unroll") for (int ks = 0; ks < 2; ++ks) { bf16x8 pf_[4]; \
            _Pragma("unroll") for (int q4 = 0; q4 < 4; ++q4) pf_[q4] = *(const LAS bf16x8*)(pbuf_ + (16 * q4 + l15) * 144 + (32 * ks + 8 * lg) * 2); \
            _Pragma("unroll") for (int db = 0; db < 4; ++db) { \
                const ldsp vp_ = Vs + (32 * ks + 8 * lg + (l15 >> 2)) * 1040 + (64 * wid + 16 * db + 4 * (l15 & 3)) * 2; \
                const s16x4 lo_ = lds_tr(vp_), hi_ = lds_tr(vp_ + 4 * 1040); \
                const bf16x8 vf_ = (bf16x8){lo_[0], lo_[1], lo_[2], lo_[3], hi_[0], hi_[1], hi_[2], hi_[3]}; \
                _Pragma("unroll") for (int q4 = 0; q4 < 4; ++q4) o[db][q4] = mfma16(vf_, pf_[q4], o[db][q4]); } } } while (0)
    f32x4 o[4][4];
#pragma unroll
    for (int db = 0; db < 4; ++db)
#pragma unroll
        for (int q4 = 0; q4 < 4; ++q4) o[db][q4] = (f32x4){0.f, 0.f, 0.f, 0.f};
    { const int tid = tid_outer, lane = tid & 63, l15 = lane & 15, lg = lane >> 4;
      RET_BAR();
      RET_DMAK(0, 0); RET_DMAK(1, 1); RET_LOADV(0);
      asm volatile("s_waitcnt vmcnt(0)" ::: "memory");
      RET_STOREV();
      RET_BAR();
      RET_S(0);
      RET_LOADV(1);
      RET_BAR();
      RET_DMAK(2, 0); }
    for (int t = 0; t < 36; ++t) {
        int tl_ = tid_outer; asm volatile("" : "+v"(tl_));
        const int tid = tl_, lane = tid & 63, l15 = lane & 15, lg = lane >> 4;
        if (wid < 4) { RET_PV(t); if (t + 1 < 36) RET_S(t + 1); }
        else { if (t + 1 < 36) RET_S(t + 1); RET_PV(t); }
        RET_BAR();
        asm volatile("s_waitcnt vmcnt(0)" ::: "memory");
        if (t + 1 < 36) RET_STOREV();
        if (t + 2 < 36) RET_LOADV(t + 2);
        if (t + 3 < 36) RET_DMAK(t + 3, (t + 1) & 1);
        RET_BAR();
    }
#undef RET_KV
#undef RET_DMAK
#undef RET_LOADV
#undef RET_STOREV
#undef RET_S
#undef RET_PV
    const int lane = tid_outer & 63, l15 = lane & 15, lg = lane >> 4;
    LAS float* red = (LAS float*)Ps;
#pragma unroll
    for (int q4 = 0; q4 < 4; ++q4) {
        float ss = 0.f;
#pragma unroll
        for (int db = 0; db < 4; ++db)
#pragma unroll
            for (int j = 0; j < 4; ++j) ss += o[db][q4][j] * o[db][q4][j];
        ss += __shfl_xor(ss, 16); ss += __shfl_xor(ss, 32);
        if (lg == 0) red[wid * 64 + 16 * q4 + l15] = ss;
    }
    RET_BAR();
#pragma unroll
    for (int q4 = 0; q4 < 4; ++q4) {
        float tot = 0.f;
#pragma unroll
        for (int w = 0; w < 8; ++w) tot += red[w * 64 + 16 * q4 + l15];
        const float rstd = 1.0f / sqrtf(tot * (1.f / 512.f) + EPS);
        bf16_t* gp = R + (size_t)(rowq0 + 16 * q4 + l15) * 6144 + 4096 + h * 512 + 64 * wid + 4 * lg;
#pragma unroll
        for (int db = 0; db < 4; ++db) { const u32x2 g2 = *(const u32x2*)(gp + 16 * db);
            u32x2 w; w.x = cvt_pk_bf16(o[db][q4][0] * rstd * silu_f(bflo(g2.x)), o[db][q4][1] * rstd * silu_f(bfhi(g2.x)));
            w.y = cvt_pk_bf16(o[db][q4][2] * rstd * silu_f(bflo(g2.y)), o[db][q4][3] * rstd * silu_f(bfhi(g2.y)));
            *(u32x2*)(gp + 16 * db) = w; }
    }
    RET_BAR();
#undef RET_BAR
}
__device__ __forceinline__ void ret_phase(ldsp lds, bf16_t* R, const bf16_t* RC, const float* decay, const int tid, const int bx) {
    const int xcd = bx & 7, slot = bx >> 3;
    for (int i = 0; i < 4; ++i) {
        const int bh = 8 * i + xcd, b = bh >> 2, h = bh & 3;
        const float lgf2 = decay[h], lgb2 = decay[4 + h];
        ret_unit(lds, R, RC, b, h, slot, lgf2, lgb2, tid);
    }
}

#define XB_TMO      128
#define XB_XCNT(j)  (256  + 64 * (j))
#define XB_XSUB(j)  (1280 + 64 * (j))
#define XB_XGEN(j)  (2304 + 64 * (j))
#define XB_TOP      3328
#define XB_TOPGEN   3392
#define XB_SPIN_CAP (1u << 22)
__device__ __forceinline__ unsigned xb_ld(unsigned* p)              { return __hip_atomic_load(p, __ATOMIC_RELAXED, __HIP_MEMORY_SCOPE_AGENT); }
__device__ __forceinline__ unsigned xb_add(unsigned* p, unsigned v) { return __hip_atomic_fetch_add(p, v, __ATOMIC_RELAXED, __HIP_MEMORY_SCOPE_AGENT); }
__device__ __forceinline__ unsigned xb_xcc_id() { return (unsigned)__builtin_amdgcn_s_getreg((3 << 11) | 20) & 0xFu; }
#define XB_SPIN(cond, bar) do { unsigned _sp = 0; while (cond) { __builtin_amdgcn_s_sleep(1); \
    if ((++_sp & 255u) == 0u) { if (xb_ld(&(bar)[XB_TMO])) break; if (_sp > XB_SPIN_CAP) { atomicAdd(&(bar)[XB_TMO], 1u); break; } } } } while (0)
__device__ __forceinline__ void xcd_barrier_complete(unsigned* bar, unsigned x, unsigned& nloc, unsigned& nx) {
    const unsigned G = gridDim.x * gridDim.y * gridDim.z;
    unsigned sum, cnt, mine, sp = 0u;
    for (;;) {
        sum = 0u; cnt = 0u; mine = 0u;
#pragma unroll
        for (unsigned j = 0; j < 16; ++j) { const unsigned c = xb_ld(&bar[XB_XCNT(j)]); sum += c; cnt += (c > 0u) ? 1u : 0u; mine = (j == x) ? c : mine; }
        if (sum == G) break;
        __builtin_amdgcn_s_sleep(1);
        if ((++sp & 255u) == 0u) { if (xb_ld(&bar[XB_TMO])) break; if (sp > XB_SPIN_CAP) { atomicAdd(&bar[XB_TMO], 1u); break; } }
    }
    nloc = mine > 0u ? mine : 1u; nx = cnt > 0u ? cnt : 1u;
}
__device__ __forceinline__ void xcd_barrier(unsigned* bar, volatile LAS unsigned* st, const int tid) {
    asm volatile("s_waitcnt vmcnt(0)" ::: "memory");
    __syncthreads();
    if (tid == 0) {
        const unsigned x = xb_xcc_id();
        __builtin_amdgcn_s_waitcnt(0);
        unsigned nloc = st[0], nx = st[1];
        if (nloc == 0u) { xcd_barrier_complete(bar, x, nloc, nx); st[0] = nloc; st[1] = nx; }
        const unsigned old = xb_add(&bar[XB_XSUB(x)], 1u);
        const unsigned gen = old / nloc;
        if (old + 1u == (gen + 1u) * nloc) {
            __builtin_amdgcn_fence(__ATOMIC_RELEASE, "agent");
            asm volatile("s_waitcnt vmcnt(0)" ::: "memory");
            const unsigned og = xb_add(&bar[XB_TOP], 1u);
            const unsigned tg = og / nx;
            if (og + 1u == (tg + 1u) * nx) xb_add(&bar[XB_TOPGEN], 1u);
            else XB_SPIN(xb_ld(&bar[XB_TOPGEN]) == tg, bar);
            __builtin_amdgcn_fence(__ATOMIC_ACQUIRE, "agent");
            xb_add(&bar[XB_XGEN(x)], 1u);
            asm volatile("s_waitcnt vmcnt(0)" ::: "memory");
        } else {
            XB_SPIN(xb_ld(&bar[XB_XGEN(x)]) == gen, bar);
            __builtin_amdgcn_fence(__ATOMIC_ACQUIRE, "agent");
            asm volatile("s_waitcnt vmcnt(0)" ::: "memory");
        }
    }
    __syncthreads();
}

constexpr int N_PHASES = 42;
__global__ void __launch_bounds__(512, 2) fwd_megakernel(Args a_in) {
    extern __shared__ __attribute__((aligned(16))) unsigned char lds_raw[];
    const ldsp lds = (ldsp)lds_raw;
    cg::grid_group grid = cg::this_grid();
    { volatile LAS unsigned* st0 = (volatile LAS unsigned*)(lds + MISC_OFF);
      if (threadIdx.x < 16) st0[threadIdx.x] = 0u;
      __syncthreads();
      if (threadIdx.x == 0 && a_in.coop) (void)xb_add(&((unsigned*)(a_in.ws + WS_CTL))[XB_XCNT(xb_xcc_id())], 1u); }
    bool need_sync = false; int zz = 0;
    const int ph_lo = a_in.ph_lo, ph_hi = a_in.ph_hi, coop = a_in.coop;
    for (int ph = ph_lo; ph < ph_hi; ++ph) {
        const __attribute__((address_space(4))) Args* apz = (const __attribute__((address_space(4))) Args*)__builtin_amdgcn_kernarg_segment_ptr();
        asm volatile("" : "+s"(apz));
        const __attribute__((address_space(4))) Args& a = *apz;
        int tid = threadIdx.x; asm volatile("" : "+v"(tid));
        const int wave = __builtin_amdgcn_readfirstlane(tid >> 6);
#define LANE_ ({ int t__ = tid; asm volatile("" : "+v"(t__)); t__ & 63; })
        int bid = blockIdx.x; asm volatile("" : "+s"(bid));
        const int G = gridDim.x, gw = bid * 8 + wave, NGW = G * 8, gtid = bid * 512 + tid, NTH = G * 512;
        unsigned char* ws = a.ws;
        float* mods = (float*)(ws + WS_MODS);
        float* XC = (float*)(ws + WS_XC);
        bf16_t* H = (bf16_t*)(ws + WS_H);
        bf16_t* U = (bf16_t*)(ws + WS_U);
        bf16_t* RC = (bf16_t*)(ws + WS_RC);
        bf16_t* SIDE = (bf16_t*)(ws + WS_SIDE);
        int kind = -1, layer = 0, slot = 0;
        if (ph == 0) kind = 0; else if (ph == 41) kind = 8;
        else { layer = (ph - 1) / 10; slot = (ph - 1) % 10;
            kind = (slot == 0 || slot == 5) ? 1 : (slot == 1 || slot == 6) ? 2 : slot == 2 ? 3 : slot == 3 ? 4 : (slot == 4 || slot == 9) ? 5 : slot == 7 ? 6 : 7; }
        const int mixer = layer % 3;
        if (kind == 4 && mixer == 0) continue;
        if (kind == 6) continue;
        if (kind == 3 && mixer != 0) continue;
        const bool fusedn = (G == 256);
        const int rows_full = (layer < 2) ? MT : ML;
        const int nrows = (kind == 1) ? ((slot == 0 && layer == 2) ? MT : rows_full) : 0;
        const int nrow0 = (kind == 1 && fusedn && ph > 1) ? ML : 0;
        if (kind == 1 && nrows <= nrow0) continue;
        if (kind == 8 && fusedn) continue;
        const int zr = (kind == 5) ? PROBE_GR : (kind == 7) ? PROBE_GB : 1;
        const bool dummy = zz + 1 < zr;
        if (need_sync && coop) { for (int z = 0; z <= PROBE_SYNC; ++z) { if (a.pad == 0x5eed) grid.sync(); else xcd_barrier((unsigned*)(ws + WS_CTL), (volatile LAS unsigned*)(lds + MISC_OFF), tid); } }
        need_sync = true;
        const float* modl = mods + (size_t)layer * 9 * NMOD;
        const float* xs_lat = (layer == 0 && slot <= 4) ? a.x : a.out;
        const float* xs_ctx = XC;
        if (kind == 0) {
#ifndef NO_PRO
 for (int z = 0; z < PROBE_PRO; ++z) prologue(a, lds, gw, NGW, wave, LANE_, tid, bid, G);
#endif
 }
        else if (kind == 1) {
            const bool mix = slot == 0; const int rows = nrows;
            const bool haspart = (ph > 1) && (ph <= 21);
            norm_phase(xs_lat, xs_ctx, haspart ? (const float*)(ws + WS_PARTA) : nullptr, (const float*)(ws + WS_PARTB), XC, nrow0, rows, (mix ? a.norm_mix_g : a.norm_ffn_g) + layer * D, modl, mix ? 0 : 3072, mix ? 1024 : 4096, H, gw, NGW, LANE_);
        } else if (kind == 2) {
            const bool retl = (slot == 1 && mixer == 2);
            if (retl) {
                pg8::Gemm g{H, (const bf16_t*)(ws + WS_RIN), ML, 2048, D, D, D}; pg8::EpiRope ER{U, 6144, 4};
                pg8::StaticOrder S; S.init(g.M, g.N, G, bid);
                pg8::gemm_phase<pg8::EpiRope>(lds, g, S, ER, tid);
            }
            if (slot == 1 && mixer == 1) {
                pg8::Gemm g{H, (const bf16_t*)(ws + WS_AQKV), MT, 1536, D, D, D}; pg8::EpiQKV EQ{U, a.attn_qg, a.attn_kg};
                pg8::StaticOrder S; S.init(g.M, g.N, G, bid);
                pg8::gemm_phase<pg8::EpiQKV>(lds, g, S, EQ, tid);
            }
            if (slot == 6) {
                pg8::Gemm g{H, (const bf16_t*)(ws + WS_UP) + (size_t)layer * DFF2 * D, rows_full, DFF2, D, D, D};
                pg8::EpiGate EG{U, SIDE, a.ffn_conv_k + (size_t)layer * 3 * DFF2, a.ffn_conv_b + (size_t)layer * DFF2};
                pg8::StaticOrder S; S.init(g.M, g.N, G, bid);
                pg8::gemm_phase<pg8::EpiGate>(lds, g, S, EG, tid);
            }
            const int nrep = retl ? 2 : ((slot == 1 && mixer == 1) || slot == 6) ? 0 : 1;
            for (int rep0 = 0; rep0 < nrep * PROBE_GS; ++rep0) { const int rep = rep0 % nrep;
                pg8::Gemm g; pg8::EpiStore E;
                if (mixer == 0) { g = pg8::Gemm{H, (const bf16_t*)(ws + WS_CIN) + (size_t)(layer / 3) * 3072 * D, rows_full, 3072, D, D, D}; E = pg8::EpiStore{U, 3072, nullptr, 0, 1.0f}; }
                else if (rep == 0) { g = pg8::Gemm{H, (const bf16_t*)(ws + WS_RIN) + (size_t)2048 * D, ML, 4096, D, D, D}; E = pg8::EpiStore{U + 2048, 6144, nullptr, 0, 1.0f}; }
                else { g = pg8::Gemm{H + (size_t)ML * D, (const bf16_t*)(ws + WS_RIN) + (size_t)1024 * D, MC, 3072, D, D, D}; E = pg8::EpiStore{RC, 3072, nullptr, 4, 0.0625f}; }
                pg8::StaticOrder S; S.init(g.M, g.N, G, bid);
#ifndef NO_GS
                pg8::gemm_phase<pg8::EpiStore>(lds, g, S, E, tid);
#endif
            }
            { const int cset = (ph == 2) ? 1 : (ph == 7) ? 2 : (ph == 17) ? 3 : 0, c0 = (ph == 2) ? 96 : 48;
              if (cset != 0 && G == 256 && bid >= c0) convert_set(a, lds, cset, (bid - c0) * 8 + wave, (256 - c0) * 8, wave, LANE_); }
        } else if (kind == 3) {
#ifndef NO_PREP
            if (mixer == 0) for (int z = 0; z < PROBE_EW; ++z) convgate_phase(U, H, rows_full, a.conv_k + (size_t)(layer / 3) * 3 * D, gw, NGW, LANE_);
            else if (mixer == 1) attnprep_phase(U, a.attn_qg, a.attn_kg, gw, NGW, LANE_);
            else retprep_phase(U, RC, gw, NGW, LANE_);
#endif
        } else if (kind == 4) {
#ifndef NO_ATT
            if (mixer == 1) for (int z = 0; z < PROBE_ATT; ++z) attn_phase(lds, (char*)lds_raw, U, H, tid, bid);
#endif
#ifndef NO_RET
            if (mixer == 2) ret_phase(lds, U, RC, mods + 4 * 9 * NMOD, tid, bid);
#endif
        } else if (kind == 5) {
            const int nrep = (layer < 2) ? 3 : 1;
            for (int rep = 0; rep < nrep; ++rep) {
                pg8::Gemm g; int goff = 2048;
                if (slot == 9) { g = pg8::Gemm{U, (const bf16_t*)(ws + WS_DN) + (size_t)layer * D * DFF, ML, D, DFF, DFF, DFF}; goff = 5120; }
                else if (mixer == 0) { g = pg8::Gemm{H, (const bf16_t*)(ws + WS_COUT) + (size_t)(layer / 3) * D * D, ML, D, D, D, D}; }
                else if (mixer == 1) { g = pg8::Gemm{H, (const bf16_t*)(ws + WS_AOUT), ML, D, D, D, D}; }
                else { g = pg8::Gemm{U + 4096, (const bf16_t*)(ws + WS_ROUT), ML, D, 2048, 6144, 2048}; }
                int split = 1, cid = bid, kq0 = 0; unsigned kpart = 0u, koff0 = 0u;
                float* part = nullptr;
                if (rep > 0) {
                    g.A += (size_t)ML * g.lda; g.M = MC; split = 2; part = (float*)(ws + (rep == 1 ? WS_PARTA : WS_PARTB));
                    if (slot == 9) { if (rep == 1) { g.K = 768; kpart = 1536u; } else { g.K = 640; kpart = 1280u; koff0 = 3072u; cid = (bid + 192) & 255; } }
                    else { g.K = 256; kpart = 512u; if (rep == 2) { koff0 = 1024u; cid = (bid + 192) & 255; } }
                }
                pg8::StaticOrder S; S.init(g.M, g.N, G, cid, split, kpart, koff0, kq0);
                if (rep == 0 && fusedn) {
                    const bool fin = (slot == 9 && layer == 3); const int nl = (slot == 9) ? layer + 1 : layer;
                    const float* gain = fin ? a.final_g : ((slot == 9) ? a.norm_mix_g : a.norm_ffn_g) + nl * D;
                    const int inst = layer * 2 + (slot == 9 ? 1 : 0);
                    pg8::EpiResidNorm EN{xs_lat, a.out, modl + goff, gain, mods + (size_t)(fin ? 0 : nl) * 9 * NMOD, (slot == 9) ? 0 : 3072, (slot == 9) ? 1024 : 4096,
                                         H, (unsigned*)(ws + WS_XBUF), (unsigned*)(ws + WS_CTL + 16384 + inst * 16384), fin ? 1 : 0};
                    pg8::gemm_phase<pg8::EpiResidNorm>(lds, g, S, EN, tid);
                } else {
                    pg8::EpiResid E{xs_lat, XC, a.out, XC, dummy ? (const float*)(ws + WS_CTL + CTL_ZEROS) : modl + goff, rep ? ML : 0, part};
                    pg8::gemm_phase<pg8::EpiResid>(lds, g, S, E, tid);
                }
            }
        } else if (kind == 6) { for (int z = 0; z < PROBE_EW; ++z) ffngate_a(U, SIDE, rows_full, gtid, NTH); }
        else if (kind == 7) {
#ifndef NO_GB
 ffngate_fix(U, SIDE, rows_full, a.ffn_conv_k + (size_t)layer * 3 * DFF2, a.ffn_conv_b + (size_t)layer * DFF2, gw, NGW, LANE_);
#endif
 }
        else if (kind == 8) { final_phase(a.out, a.final_g, gw, NGW, LANE_); }
        if (dummy) { ++zz; --ph; } else zz = 0;
    }
}

extern "C" void kernel_launch(void* const* d_in, const int* in_sizes, int n_in, void* d_out, int out_size, void* d_ws, size_t ws_size, hipStream_t stream) {
    static int grid = 0;
    if (grid == 0) {
        if (n_in != 23 || out_size != ML * D || ws_size < WS_END) { fprintf(stderr, "kernel_launch: unexpected shapes (n_in %d out %d ws %zu)\n", n_in, out_size, ws_size); grid = -1; return; }
        int dev = 0, cus = 0, per_cu = 0;
        hipGetDevice(&dev);
        hipDeviceGetAttribute(&cus, hipDeviceAttributeMultiprocessorCount, dev);
        hipFuncSetAttribute((const void*)fwd_megakernel, hipFuncAttributeMaxDynamicSharedMemorySize, LDS_BYTES);
        hipOccupancyMaxActiveBlocksPerMultiprocessor(&per_cu, (const void*)fwd_megakernel, 512, LDS_BYTES);
        (void)hipGetLastError();
        if (per_cu < 1) per_cu = 1;
        grid = cus;
        if (grid != 256) fprintf(stderr, "kernel_launch: %d CUs (expected 256)\n", grid);
    }
    if (grid < 0) return;
    if (hipMemsetAsync((char*)d_ws + WS_CTL, 0, CTL_BYTES, stream) != hipSuccess) { fprintf(stderr, "kernel_launch: memset failed\n"); return; }
    Args a{};
    const float** ap = (const float**)&a;
    for (int i = 0; i < 23; ++i) ap[i] = (const float*)d_in[i];
    a.out = (float*)d_out; a.ws = (unsigned char*)d_ws;
#if MK_PER_PHASE
    for (int ph = 0; ph < N_PHASES; ++ph) { a.ph_lo = ph; a.ph_hi = ph + 1; a.coop = 0; hipLaunchKernelGGL(fwd_megakernel, dim3(grid), dim3(512), LDS_BYTES, stream, a); }
#else
    a.ph_lo = 0; a.ph_hi = N_PHASES; a.coop = 1;
    void* args[] = {&a};
    hipError_t e = hipLaunchCooperativeKernel((const void*)fwd_megakernel, dim3(grid), dim3(512), args, LDS_BYTES, stream);
    if (e != hipSuccess) fprintf(stderr, "cooperative launch failed: %s (grid %d)\n", hipGetErrorString(e), grid);
#endif
}
```

```cpp
#include <hip/hip_runtime.h>
#include <hip/hip_cooperative_groups.h>
#include <hip/hip_bf16.h>
#include <cmath>
#include <cstdio>
#include <cstdint>
namespace cg = cooperative_groups;

#define LAS __attribute__((address_space(3)))
typedef unsigned short bf16_t;
typedef short bf16x8 __attribute__((ext_vector_type(8)));
typedef short s16x4 __attribute__((ext_vector_type(4)));
typedef float f32x4 __attribute__((ext_vector_type(4)));
typedef float f32x2 __attribute__((ext_vector_type(2)));
typedef unsigned u32x4 __attribute__((ext_vector_type(4)));
typedef unsigned u32x2 __attribute__((ext_vector_type(2)));
typedef LAS unsigned char* ldsp;

#define PROBE_SYNC 0
#define PROBE_ATT 1
#define PROBE_RET 1
#define PROBE_GS 1
#define PROBE_EW 1
#define PROBE_GR 1
#define PROBE_GB 1
#define PROBE_PRO 1
#ifndef MK_PER_PHASE
#define MK_PER_PHASE 0
#endif

constexpr int D = 1024, NB = 8, SEQ = 2048, CL = 256, ML = NB * SEQ, MC = NB * CL, MT = ML + MC;
constexpr int DFF = 2816, DFF2 = 5632, NMOD = 6144;
constexpr float EPS = 1e-6f;
constexpr float C2 = 0.125f * 1.4426950408889634f;
constexpr float LOG2_THETA = 13.287712379549449f;
constexpr float INV_2PI = 0.15915494309189535f;

constexpr size_t MiB = 1u << 20;
constexpr size_t WS_MODS = 0;
constexpr size_t WS_CIN = 1 * MiB, WS_COUT = 13 * MiB, WS_AQKV = 17 * MiB, WS_AOUT = 20 * MiB, WS_RIN = 22 * MiB, WS_ROUT = 34 * MiB,
                 WS_UP = 38 * MiB, WS_DN = 82 * MiB;
constexpr size_t WS_XC = 104 * MiB;
constexpr size_t WS_H = 112 * MiB;
constexpr size_t WS_U = 148 * MiB;
constexpr size_t WS_RC = 340 * MiB;
constexpr size_t WS_SIDE = 352 * MiB;
constexpr size_t WS_CTL = 366 * MiB, CTL_BYTES = 262144, CTL_ZEROS = 16384;
constexpr size_t WS_PARTA = 346 * MiB, WS_PARTB = 367 * MiB;
constexpr size_t WS_XBUF = 365 * MiB;
constexpr size_t WS_END = 383 * MiB;
constexpr int LDS_BYTES = 163840, MISC_OFF = LDS_BYTES - 64;

__device__ __forceinline__ unsigned cvt_pk_bf16(float lo, float hi) { unsigned r; asm volatile("v_cvt_pk_bf16_f32 %0, %1, %2" : "=v"(r) : "v"(lo), "v"(hi)); return r; }
__device__ __forceinline__ float bflo(unsigned w) { return __uint_as_float(w << 16); }
__device__ __forceinline__ float bfhi(unsigned w) { return __uint_as_float(w & 0xffff0000u); }
__device__ __forceinline__ float wave_sum(float v) {
#pragma unroll
    for (int o = 1; o < 64; o <<= 1) v += __shfl_xor(v, o);
    return v;
}
__device__ __forceinline__ float silu_f(float x) { return x * __builtin_amdgcn_rcpf(1.0f + __builtin_amdgcn_exp2f(x * -1.4426950408889634f)); }
__device__ __forceinline__ f32x4 mfma16(bf16x8 a, bf16x8 b, f32x4 c) { return __builtin_amdgcn_mfma_f32_16x16x32_bf16(a, b, c, 0, 0, 0); }
typedef short v4i16_t __attribute__((ext_vector_type(4)));
__device__ __forceinline__ s16x4 lds_tr(ldsp p) { return __builtin_bit_cast(s16x4, __builtin_amdgcn_ds_read_tr16_b64_v4i16((LAS v4i16_t*)p)); }

namespace pg8 {
constexpr int BM = 256, BK = 64, HALF = 128, HTB = HALF * BK * 2, STAGE_BYTES = 8 * HTB, NXCD = 8, WGM = 4;
__device__ __forceinline__ int lds_byte(int r, int c) { const int st = (r >> 4) * 2 + (c >> 5), rr = r & 15, cc = c & 31, ob = rr * 64 + cc * 2; return st * 1024 + (ob ^ (((ob >> 9) & 1) << 5)); }
__device__ __forceinline__ void stage_rc(int b, int& R, int& C) { const int st = b / 1024, sb = b % 1024, swz = sb ^ (((sb >> 9) & 1) << 5); R = (st >> 1) * 16 + swz / 64; C = (st & 1) * 32 + (swz % 64) / 2; }
__device__ __forceinline__ int perm32(int rho) { const int n = rho >> 4, i = rho & 15; return 8 * (i >> 2) + 4 * n + (i & 3); }
struct Unit { int pm, pn; unsigned koff; int kq; };
struct Gemm { const bf16_t* A; const bf16_t* Bt; int M, N, K, lda, ldb; };
struct StaticOrder {
    int nM, nN, nwg, G, c, split, kq0; unsigned kpart, koff0;
    __device__ void init(int M, int N, int G_, int c_, int split_ = 1, unsigned kpart_ = 0u, unsigned koff0_ = 0u, int kq0_ = 0) { nM = M / BM; nN = N / BM; nwg = nM * nN; G = G_; c = c_; split = split_; kpart = kpart_; koff0 = koff0_; kq0 = kq0_; }
    __device__ __forceinline__ bool next(int i, Unit& u) const {
        const long L = (long)i * G + c;
        if (L >= (long)nwg * split) return false;
        int pm, pn, kq = 0; unsigned koff = 0u;
        if (split > 1) { kq = (int)(L % split); const int t = (int)(L / split); pm = t % nM; pn = t / nM; koff = koff0 + (unsigned)kq * kpart; }
        else {
            int wgid = (int)L; { const int q = nwg / NXCD, r = nwg % NXCD, xcd = wgid % NXCD, off = wgid / NXCD; wgid = (xcd < r ? xcd * (q + 1) : r * (q + 1) + (xcd - r) * q) + off; }
            const int nig = WGM * nN, gid = wgid / nig, fm = gid * WGM, gsz = (nM - fm) < WGM ? (nM - fm) : WGM;
            pm = fm + ((wgid % nig) % gsz); pn = (wgid % nig) / gsz; }
        u.pm = pm; u.pn = pn; u.koff = koff; u.kq = kq0 + kq; return true;
    }
};
struct EpiStore {
    static constexpr bool PERM = true, AFTER_DRAIN = false; static constexpr int BMAP = 0;
    bf16_t* O; int ldc; bf16_t* side; int scale_tiles; float scale;
    __device__ __forceinline__ void operator()(const f32x4 (&acc)[2][2][4][2], const Unit& u, int wr, int wc, int fr, int fq) const {
        char* base = (char*)(O + (size_t)(u.pm * BM) * ldc + u.pn * BM);
        char* sbase = (char*)(side + (size_t)(u.pm * 16) * ldc + u.pn * BM);
        const unsigned ldb = (unsigned)ldc * 2u; const float sc_ = (u.pn < scale_tiles) ? scale : 1.0f;
        unsigned off0 = (unsigned)(wr * 64 + fr) * ldb + (unsigned)(wc * 32 + 8 * fq) * 2u; asm volatile("" : "+v"(off0));
#pragma unroll
        for (int ai = 0; ai < 2; ++ai)
#pragma unroll
            for (int m = 0; m < 4; ++m) { const unsigned off = off0 + (unsigned)(ai * HALF + m * 16) * ldb;
#pragma unroll
                for (int bj = 0; bj < 2; ++bj) { const f32x4 v0 = acc[ai][bj][m][0] * sc_, v1 = acc[ai][bj][m][1] * sc_;
                    u32x4 w; w.x = cvt_pk_bf16(v0[0], v0[1]); w.y = cvt_pk_bf16(v0[2], v0[3]); w.z = cvt_pk_bf16(v1[0], v1[1]); w.w = cvt_pk_bf16(v1[2], v1[3]);
                    *(u32x4*)(base + off + bj * HALF * 2) = w;
                    if (side != nullptr && ((fr == 0 && (m & 1) == 0) || (fr == 15 && (m & 1) == 1))) {
                        const int slot = (ai * 4 + wr * 2 + (m >> 1)) * 2 + (m & 1);
                        *(u32x4*)(sbase + (unsigned)slot * ldb + (unsigned)(wc * 32 + 8 * fq) * 2u + bj * HALF * 2) = w; } } }
    }
};
struct EpiResid {
    static constexpr bool PERM = false, AFTER_DRAIN = false; static constexpr int BMAP = 0;
    const float* xs_lat; const float* xs_ctx; float* xd_lat; float* xd_ctx; const float* gate; int row_base; float* part;
    __device__ __forceinline__ void operator()(const f32x4 (&acc)[2][2][4][2], const Unit& u, int wr, int wc, int fr, int fq) const {
        const int rowt = row_base + u.pm * BM; const bool lat = rowt < ML;
        const int b = lat ? (rowt >> 11) : NB;
        const char* xs = (const char*)((lat ? xs_lat + (size_t)rowt * D : xs_ctx + (size_t)(rowt - ML) * D) + u.pn * BM);
        char* xd = (char*)((part != nullptr ? part + (size_t)u.kq * MC * D + (size_t)(rowt - ML) * D : lat ? xd_lat + (size_t)rowt * D : xd_ctx + (size_t)(rowt - ML) * D) + u.pn * BM);
        const char* gp = (const char*)(gate + (size_t)b * NMOD + u.pn * BM);
        const unsigned coff = (unsigned)(wc * 32 + 4 * fq) * 4u;
        unsigned off0 = (unsigned)(wr * 64 + fr) * (D * 4u) + coff; asm volatile("" : "+v"(off0));
#pragma unroll
        for (int bj = 0; bj < 2; ++bj)
#pragma unroll
            for (int n = 0; n < 2; ++n) { const f32x4 gv = *(const f32x4*)(gp + coff + (bj * HALF + n * 16) * 4);
#pragma unroll
                for (int ai = 0; ai < 2; ++ai) {
#pragma unroll
                    for (int m = 0; m < 4; ++m) { const unsigned off = off0 + (unsigned)((ai * HALF + m * 16) * D + bj * HALF + n * 16) * 4u;
                        if (part != nullptr) { *(f32x4*)(xd + off) = gv * acc[ai][bj][m][n]; }
                        else { const f32x4 xv = *(const f32x4*)(xs + off); *(f32x4*)(xd + off) = xv + gv * acc[ai][bj][m][n]; } }
                    } asm volatile("" ::: "memory"); }
    }
};

struct EpiRope {
    static constexpr bool PERM = false, AFTER_DRAIN = false; static constexpr int BMAP = 1;
    bf16_t* O; int ldc; int q_tiles;
    __device__ __forceinline__ void operator()(const f32x4 (&acc)[2][2][4][2], const Unit& u, int wr, int wc, int fr, int fq) const {
        char* base = (char*)(O + (size_t)(u.pm * BM) * ldc + u.pn * BM);
        const unsigned ldb = (unsigned)ldc * 2u; const float sc_ = (u.pn < q_tiles) ? 1.0f : 0.0625f;
        const int w0 = wc * 32 + 4 * fq;
        unsigned off0 = (unsigned)(wr * 64 + fr) * ldb + (unsigned)((w0 < 64 ? w0 : w0 + 64)) * 2u; asm volatile("" : "+v"(off0));
        float inv[2][4];
#pragma unroll
        for (int n = 0; n < 2; ++n)
#pragma unroll
            for (int j = 0; j < 4; ++j) inv[n][j] = __builtin_amdgcn_exp2f(-(float)((w0 + 16 * n + j) & 63) * (LOG2_THETA / 64.f)) * INV_2PI;
#pragma unroll
        for (int ai = 0; ai < 2; ++ai)
#pragma unroll
            for (int m = 0; m < 4; ++m) {
                int frl = fr; asm volatile("" : "+v"(frl));
                const int t = (u.pm * BM + ai * HALF + wr * 64 + m * 16 + frl) & (SEQ - 1);
                const float pos = (wc >= 2) ? (float)(t & 63) : (float)(t >> 6);
                const unsigned off = off0 + (unsigned)(ai * HALF + m * 16) * ldb;
#pragma unroll
                for (int n = 0; n < 2; ++n) { float o1[4], o2[4];
#pragma unroll
                    for (int j = 0; j < 4; ++j) { float tr = pos * inv[n][j]; tr -= rintf(tr);
                        const float sn = __builtin_amdgcn_sinf(tr), cs = __builtin_amdgcn_cosf(tr);
                        const float x1 = acc[ai][0][m][n][j], x2 = acc[ai][1][m][n][j];
                        o1[j] = (x1 * cs - x2 * sn) * sc_; o2[j] = (x1 * sn + x2 * cs) * sc_; }
                    u32x2 a1, a2; a1.x = cvt_pk_bf16(o1[0], o1[1]); a1.y = cvt_pk_bf16(o1[2], o1[3]); a2.x = cvt_pk_bf16(o2[0], o2[1]); a2.y = cvt_pk_bf16(o2[2], o2[3]);
                    *(u32x2*)(base + off + n * 32) = a1; *(u32x2*)(base + off + n * 32 + 128) = a2; } }
    }
};

struct EpiQKV {
    static constexpr bool PERM = false, AFTER_DRAIN = false; static constexpr int BMAP = 2;
    bf16_t* O; const float* qg; const float* kg;
    __device__ __forceinline__ void operator()(const f32x4 (&acc)[2][2][4][2], const Unit& u, int wr, int wc, int fr, int fq) const {
        constexpr int ldc = 1536;
        char* base = (char*)(O + (size_t)(u.pm * BM) * ldc + u.pn * BM + wc * 64);
        const unsigned ldb = (unsigned)ldc * 2u;
        unsigned off0 = (unsigned)(wr * 64 + fr) * ldb + (unsigned)(4 * fq) * 2u; asm volatile("" : "+v"(off0));
        const bool isv = u.pn == 5, isq = u.pn < 4, lat = u.pm < ML / BM;
        const float osc = isq ? C2 : 1.0f;
        const float* gp = isq ? qg : kg;
        float inv[4];
#pragma unroll
        for (int j = 0; j < 4; ++j) inv[j] = __builtin_amdgcn_exp2f(-(float)(4 * fq + j) * (LOG2_THETA / 16.f)) * INV_2PI;
#pragma unroll
        for (int ai = 0; ai < 2; ++ai)
#pragma unroll
            for (int m = 0; m < 4; ++m) {
                const unsigned off = off0 + (unsigned)(ai * HALF + m * 16) * ldb;
                float rstd = 1.0f;
                if (!isv) {
                    float ss = 0.f;
#pragma unroll
                    for (int n = 0; n < 2; ++n) { const f32x4 p = acc[ai][0][m][n], q = acc[ai][1][m][n];
                        ss += ((p[0] * p[0] + p[1] * p[1]) + (p[2] * p[2] + p[3] * p[3])) + ((q[0] * q[0] + q[1] * q[1]) + (q[2] * q[2] + q[3] * q[3])); }
                    ss += __shfl_xor(ss, 16); ss += __shfl_xor(ss, 32);
                    rstd = __builtin_amdgcn_rsqf(ss * (1.f / 64.f) + EPS);
                }
                int frl = fr; asm volatile("" : "+v"(frl));
                const int t = (u.pm * BM + ai * HALF + wr * 64 + m * 16 + frl) & (SEQ - 1);
#pragma unroll
                for (int n = 0; n < 2; ++n) {
                    f32x4 x1 = acc[ai][0][m][n], x2 = acc[ai][1][m][n];
                    if (!isv) {
                        x1 = x1 * rstd * *(const f32x4*)(gp + 32 * n + 4 * fq); x2 = x2 * rstd * *(const f32x4*)(gp + 32 * n + 4 * fq + 16);
                        if (lat) { const float pos = n ? (float)(t & 63) : (float)(t >> 6);
#pragma unroll
                            for (int j = 0; j < 4; ++j) { float tr = pos * inv[j]; tr -= rintf(tr);
                                const float sn = __builtin_amdgcn_sinf(tr), cs = __builtin_amdgcn_cosf(tr);
                                const float a1 = x1[j], a2 = x2[j]; x1[j] = a1 * cs - a2 * sn; x2[j] = a1 * sn + a2 * cs; } }
                        x1 = x1 * osc; x2 = x2 * osc;
                    }
                    u32x2 a1, a2; a1.x = cvt_pk_bf16(x1[0], x1[1]); a1.y = cvt_pk_bf16(x1[2], x1[3]); a2.x = cvt_pk_bf16(x2[0], x2[1]); a2.y = cvt_pk_bf16(x2[2], x2[3]);
                    *(u32x2*)(base + off + n * 64) = a1; *(u32x2*)(base + off + n * 64 + 32) = a2; }
                asm volatile("" ::: "memory"); }
    }
};

struct EpiGate {
    static constexpr bool PERM = true, AFTER_DRAIN = false; static constexpr int BMAP = 3;
    bf16_t* A2; bf16_t* side; const float* fk; const float* fb;
    __device__ __forceinline__ void operator()(const f32x4 (&acc)[2][2][4][2], const Unit& u, int wr, int wc, int fr_in, int fq_in) const {
        const int fr0_ = fr_in, fq0_ = fq_in;
        char* base = (char*)(A2 + (size_t)(u.pm * BM) * DFF);
        char* sbase = (char*)(side + (size_t)(u.pm * 16) * DFF2);
        int fr_l = fr0_, fq_l = fq0_; asm volatile("" : "+v"(fr_l), "+v"(fq_l));
        const int fr = fr_l, fq = fq_l;
        const int ch0 = u.pn * HALF + wc * 32 + 8 * fq;
        const unsigned off0 = (unsigned)(wr * 64 + fr) * (DFF * 2u) + (unsigned)ch0 * 2u;
        const bool f0 = fr == 0, f15 = fr == 15;
#define DPP_UP(v) __int_as_float(__builtin_amdgcn_update_dpp(0, __float_as_int(v), 0x121, 0xf, 0xf, false))
#define DPP_DN(v) __int_as_float(__builtin_amdgcn_update_dpp(0, __float_as_int(v), 0x12F, 0xf, 0xf, false))
#pragma unroll
        for (int ai = 0; ai < 2; ++ai) {
            f32x4 o[4]; u32x2 wlo[4];
#pragma unroll
            for (int n = 0; n < 2; ++n) {
                const int ch = ch0 + 4 * n;
#pragma unroll
                for (int pass = 0; pass < 2; ++pass) {
                    const int co = pass ? DFF : 0;
                    const f32x4 k0 = *(const f32x4*)(fk + co + ch), k1 = *(const f32x4*)(fk + DFF2 + co + ch), k2 = *(const f32x4*)(fk + 2 * DFF2 + co + ch), bb = *(const f32x4*)(fb + co + ch);
                    f32x4 up_prev = (f32x4){0.f, 0.f, 0.f, 0.f}, up_cur, dn_cur, dn_next;
#pragma unroll
                    for (int j = 0; j < 4; ++j) dn_cur[j] = DPP_DN(acc[ai][pass][0][n][j]);
#pragma unroll
                    for (int m = 0; m < 4; ++m) {
                        const f32x4 xv = acc[ai][pass][m][n];
#pragma unroll
                        for (int j = 0; j < 4; ++j) { up_cur[j] = DPP_UP(xv[j]); dn_next[j] = (m < 3) ? DPP_DN(acc[ai][pass][m < 3 ? m + 1 : 3][n][j]) : 0.f; }
                        const f32x4 xp = f0 ? up_prev : up_cur, xn = f15 ? dn_next : dn_cur;
                        const f32x4 c = (k0 * xp + k1 * xv) + (k2 * xn + bb);
                        if (pass == 0) o[m] = c;
                        else { f32x4 e;
#pragma unroll
                            for (int j = 0; j < 4; ++j) e[j] = __builtin_amdgcn_rcpf(1.0f + __builtin_amdgcn_exp2f(c[j] * -1.4426950408889634f));
                            o[m] = o[m] * (c * e); }
                        up_prev = up_cur; dn_cur = dn_next; }
                }
                if (n == 0) {
#pragma unroll
                    for (int m = 0; m < 4; ++m) { wlo[m].x = cvt_pk_bf16(o[m][0], o[m][1]); wlo[m].y = cvt_pk_bf16(o[m][2], o[m][3]); }
                } else {
#pragma unroll
                    for (int m = 0; m < 4; ++m) { u32x4 w; w.x = wlo[m].x; w.y = wlo[m].y; w.z = cvt_pk_bf16(o[m][0], o[m][1]); w.w = cvt_pk_bf16(o[m][2], o[m][3]);
                        *(u32x4*)(base + off0 + (unsigned)(ai * HALF + m * 16) * (DFF * 2u)) = w; }
                }
                if (fr < 2 || fr >= 14) { const int k = fr < 2 ? fr : fr - 12;
                    const f32x4 xv = fr < 2 ? acc[ai][0][0][n] : acc[ai][0][3][n], yv = fr < 2 ? acc[ai][1][0][n] : acc[ai][1][3][n];
                    char* sp = sbase + (size_t)((2 * ai + wr) * 4 + k) * (DFF2 * 2) + (size_t)ch * 2;
                    u32x2 a, b; a.x = cvt_pk_bf16(xv[0], xv[1]); a.y = cvt_pk_bf16(xv[2], xv[3]); b.x = cvt_pk_bf16(yv[0], yv[1]); b.y = cvt_pk_bf16(yv[2], yv[3]);
                    *(u32x2*)sp = a; *(u32x2*)(sp + DFF * 2) = b; }
            }
        }
#undef DPP_UP
#undef DPP_DN
    }
};

struct EpiResidNorm {
    static constexpr bool PERM = false, AFTER_DRAIN = true; static constexpr int BMAP = 0;
    const float* xs; float* xd; const float* gate;
    const float* gain; const float* modn; int shoff, scoff;
    bf16_t* H; unsigned* xbuf; unsigned* cnt; int fin;
    __device__ __forceinline__ void operator()(const f32x4 (&)[2][2][4][2], const Unit&, int, int, int, int) const {}
    __device__ __forceinline__ void fused(f32x4 (&acc)[2][2][4][2], const Unit& u, int wr, int wc, int fr, int fq, ldsp lds, int wid, int lane) const {
        const int rowt = u.pm * BM, b = rowt >> 11;
        const char* xsb = (const char*)(xs + (size_t)rowt * D + u.pn * BM);
        char* xdb = (char*)(xd + (size_t)rowt * D + u.pn * BM);
        const char* gp = (const char*)(gate + (size_t)b * NMOD + u.pn * BM);
        const unsigned coff = (unsigned)(wc * 32 + 4 * fq) * 4u;
        unsigned off0 = (unsigned)(wr * 64 + fr) * (D * 4u) + coff; asm volatile("" : "+v"(off0));
#pragma unroll
        for (int bj = 0; bj < 2; ++bj)
#pragma unroll
            for (int n = 0; n < 2; ++n) { const f32x4 gv = *(const f32x4*)(gp + coff + (bj * HALF + n * 16) * 4);
#pragma unroll
                for (int ai = 0; ai < 2; ++ai) {
#pragma unroll
                    for (int m = 0; m < 4; ++m) { const unsigned off = off0 + (unsigned)((ai * HALF + m * 16) * D + bj * HALF + n * 16) * 4u;
                        const f32x4 xv = *(const f32x4*)(xsb + off); acc[ai][bj][m][n] = xv + gv * acc[ai][bj][m][n];
                        if (!fin) *(f32x4*)(xdb + off) = acc[ai][bj][m][n]; }
                    asm volatile("" ::: "memory"); } }
        LAS float* P = (LAS float*)lds;
        LAS float* Sx = (LAS float*)(lds + 4096);
#pragma unroll
        for (int ai = 0; ai < 2; ++ai)
#pragma unroll
            for (int m = 0; m < 4; ++m) { float sq = 0.f;
#pragma unroll
                for (int bj = 0; bj < 2; ++bj)
#pragma unroll
                    for (int n = 0; n < 2; ++n) { const f32x4 v = acc[ai][bj][m][n]; sq += (v[0] * v[0] + v[1] * v[1]) + (v[2] * v[2] + v[3] * v[3]); }
                sq += __shfl_xor(sq, 16); sq += __shfl_xor(sq, 32);
                if (fq == 0) P[(ai * HALF + wr * 64 + m * 16 + fr) * 4 + wc] = sq; }
        asm volatile("s_waitcnt lgkmcnt(0)" ::: "memory"); __builtin_amdgcn_s_barrier(); asm volatile("" ::: "memory");
        const int row = wid * 32 + (lane & 31);
        unsigned* slot = xbuf + ((size_t)(u.pm * BM + row)) * 4;
        if (lane < 32) { const float t = ((P[row * 4 + 0] + P[row * 4 + 1]) + P[row * 4 + 2]) + P[row * 4 + 3];
            __hip_atomic_store(slot + u.pn, __float_as_uint(t), __ATOMIC_RELAXED, __HIP_MEMORY_SCOPE_AGENT); }
        asm volatile("s_waitcnt vmcnt(0)" ::: "memory");
        if (lane == 0) __hip_atomic_fetch_add(cnt + 64 * u.pm, 1u, __ATOMIC_RELAXED, __HIP_MEMORY_SCOPE_AGENT);
        if (wid == 0) { unsigned sp = 0u;
            while ((unsigned)__builtin_amdgcn_readfirstlane(__hip_atomic_load(cnt + 64 * u.pm, __ATOMIC_RELAXED, __HIP_MEMORY_SCOPE_AGENT)) < 32u) { __builtin_amdgcn_s_sleep(2); if (++sp > (1u << 22)) break; }
            __builtin_amdgcn_fence(__ATOMIC_ACQUIRE, "agent"); }
        asm volatile("s_waitcnt vmcnt(0) lgkmcnt(0)" ::: "memory"); __builtin_amdgcn_s_barrier(); asm volatile("" ::: "memory");
        if (lane < 32) {
            const float t0 = __uint_as_float(__hip_atomic_load(slot + 0, __ATOMIC_RELAXED, __HIP_MEMORY_SCOPE_AGENT)), t1 = __uint_as_float(__hip_atomic_load(slot + 1, __ATOMIC_RELAXED, __HIP_MEMORY_SCOPE_AGENT));
            const float t2 = __uint_as_float(__hip_atomic_load(slot + 2, __ATOMIC_RELAXED, __HIP_MEMORY_SCOPE_AGENT)), t3 = __uint_as_float(__hip_atomic_load(slot + 3, __ATOMIC_RELAXED, __HIP_MEMORY_SCOPE_AGENT));
            Sx[row] = 1.0f / sqrtf((((t0 + t1) + t2) + t3) * (1.f / D) + EPS); }
        asm volatile("s_waitcnt vmcnt(0) lgkmcnt(0)" ::: "memory"); __builtin_amdgcn_s_barrier(); asm volatile("" ::: "memory");
        const int colt = u.pn * BM + wc * 32 + 4 * fq;
        const float* mb = modn + (size_t)b * NMOD;
#pragma unroll
        for (int bj = 0; bj < 2; ++bj)
#pragma unroll
            for (int n = 0; n < 2; ++n) { const int c = colt + bj * HALF + n * 16;
                f32x4 gc = *(const f32x4*)(gain + c), sh = (f32x4){0.f, 0.f, 0.f, 0.f};
                if (!fin) { gc = gc * (*(const f32x4*)(mb + scoff + c) + 1.0f); sh = *(const f32x4*)(mb + shoff + c); }
#pragma unroll
                for (int ai = 0; ai < 2; ++ai)
#pragma unroll
                    for (int m = 0; m < 4; ++m) { const int r = ai * HALF + wr * 64 + m * 16 + fr; const float rs = Sx[r];
                        const f32x4 y = (acc[ai][bj][m][n] * rs) * gc + sh;
                        if (fin) *(f32x4*)(xd + (size_t)(rowt + r) * D + c) = y;
                        else { u32x2 w; w.x = cvt_pk_bf16(y[0], y[1]); w.y = cvt_pk_bf16(y[2], y[3]); *(u32x2*)(H + (size_t)(rowt + r) * D + c) = w; } } }
        asm volatile("s_waitcnt lgkmcnt(0)" ::: "memory"); __builtin_amdgcn_s_barrier(); asm volatile("" ::: "memory");
    }
};

template <class Epi>
__device__ __forceinline__ void gemm_phase(ldsp lds, const Gemm g, const StaticOrder& S, const Epi& E, const int tid) {
    const int wid = __builtin_amdgcn_readfirstlane(tid >> 6), lane = tid & 63, wr = wid >> 2, wc = wid & 3, fr = lane & 15, fq = lane >> 4;
    const int K = g.K, nt = K / BK, lda = g.lda;
    unsigned voffA[2], voffB[2];
#pragma unroll
    for (int i = 0; i < 2; ++i) { int R, C; stage_rc(tid * 16 + i * 8192, R, C); const int Rb = Epi::PERM ? ((R & ~31) + perm32(R & 31)) : (Epi::BMAP == 1 ? (R + (R >= 64 ? 64 : 0)) : Epi::BMAP == 2 ? ((R >> 5) * 64 + (R & 15) + ((R & 16) ? 32 : 0)) : R);
        voffA[i] = (unsigned)(R * lda + C) * 2u; voffB[i] = (unsigned)(Rb * g.ldb + C) * 2u; }
    const size_t kstep = (size_t)(BK * 2);
    const size_t hstepA = (size_t)HALF * lda * 2, hstepB = (size_t)(Epi::BMAP == 1 ? 64 : Epi::BMAP == 2 ? 16 : Epi::BMAP == 3 ? DFF : HALF) * g.ldb * 2;
    const size_t tstepA = 2 * hstepA, tstepB = (size_t)(Epi::BMAP == 3 ? HALF : BM) * g.ldb * 2;
    const unsigned ldsw = (unsigned)wid * 1024u;
    const int aoff = lds_byte(wr * 64 + fr, fq * 8), boff = lds_byte(wc * 32 + fr, fq * 8);
#define PG8_SA(b, h) (((b) * 2 + (h)) * HTB)
#define PG8_SB(b, h) ((4 + (b) * 2 + (h)) * HTB)
#define PG8_STAGE(bufoff, gbase, voff) do { _Pragma("unroll") for (int _i = 0; _i < 2; ++_i) \
        __builtin_amdgcn_global_load_lds((const unsigned*)((const char*)(gbase) + (voff)[_i]), (LAS unsigned*)(lds + (bufoff) + ldsw + _i * 8192), 16, 0, 0); } while (0)
#define PG8_LDA(dst, b, h) do { _Pragma("unroll") for (int m = 0; m < 4; ++m) _Pragma("unroll") for (int k = 0; k < 2; ++k) dst[m][k] = *(const LAS bf16x8*)(lds + PG8_SA(b, h) + aoff + m * 2048 + k * 1024); } while (0)
#define PG8_LDB(dst, b, h) do { _Pragma("unroll") for (int n = 0; n < 2; ++n) _Pragma("unroll") for (int k = 0; k < 2; ++k) dst[n][k] = *(const LAS bf16x8*)(lds + PG8_SB(b, h) + boff + n * 2048 + k * 1024); } while (0)
#define PG8_MMA(ai, bj, At, Bt) do { __builtin_amdgcn_s_setprio(1); _Pragma("unroll") for (int m = 0; m < 4; ++m) _Pragma("unroll") for (int n = 0; n < 2; ++n) _Pragma("unroll") for (int k = 0; k < 2; ++k) \
        acc[ai][bj][m][n] = __builtin_amdgcn_mfma_f32_16x16x32_bf16(Bt[n][k], At[m][k], acc[ai][bj][m][n], 0, 0, 0); __builtin_amdgcn_s_setprio(0); } while (0)
#define PG8_WAIT_V(n) asm volatile("s_waitcnt vmcnt(" #n ")" ::: "memory")
#define PG8_WAIT_L(n) asm volatile("s_waitcnt lgkmcnt(" #n ")" ::: "memory")
#define PG8_BAR __builtin_amdgcn_s_barrier()
#define PG8_SCHED __builtin_amdgcn_sched_barrier(0)
    Unit cur, nxt; int ui = 0;
    if (!S.next(0, cur)) return;
    f32x4 acc[2][2][4][2];
#pragma unroll
    for (int a = 0; a < 2; ++a)
#pragma unroll
        for (int b = 0; b < 2; ++b)
#pragma unroll
            for (int m = 0; m < 4; ++m)
#pragma unroll
                for (int n = 0; n < 2; ++n) acc[a][b][m][n] = (f32x4){0.f, 0.f, 0.f, 0.f};
    bf16x8 At[4][2], B0[2][2], B1[2][2];
    const char* cA = (const char*)g.A + (size_t)cur.pm * tstepA + cur.koff; const char* cB = (const char*)g.Bt + (size_t)cur.pn * tstepB + cur.koff;
    PG8_STAGE(PG8_SB(0, 0), cB, voffB); PG8_STAGE(PG8_SB(0, 1), cB + hstepB, voffB); PG8_STAGE(PG8_SA(0, 0), cA, voffA); PG8_STAGE(PG8_SA(0, 1), cA + hstepA, voffA);
    if (wr == 1) PG8_BAR;
    PG8_WAIT_V(2); PG8_BAR;
    PG8_STAGE(PG8_SB(1, 0), cB + kstep, voffB); PG8_STAGE(PG8_SA(1, 0), cA + kstep, voffA); PG8_STAGE(PG8_SB(1, 1), cB + hstepB + kstep, voffB);
    PG8_WAIT_V(6); PG8_BAR;
    for (;;) {
        const bool has_next = S.next(ui + 1, nxt);
        const char* nA = has_next ? (const char*)g.A + (size_t)nxt.pm * tstepA + nxt.koff : cA; const char* nB = has_next ? (const char*)g.Bt + (size_t)nxt.pn * tstepB + nxt.koff : cB;
        for (int t = 0; t < nt; t += 2) {
            const bool last = (t == nt - 2);
            const char* a1 = cA + (size_t)(t + 1) * kstep;
            const char* a2 = last ? nA : cA + (size_t)(t + 2) * kstep; const char* b2 = last ? nB : cB + (size_t)(t + 2) * kstep;
            const char* a3 = a2 + kstep; const char* b3 = b2 + kstep;
            PG8_LDB(B0, 0, 0); PG8_LDB(B1, 0, 1); PG8_SCHED; PG8_LDA(At, 0, 0); PG8_STAGE(PG8_SA(1, 1), a1 + hstepA, voffA);
            PG8_WAIT_V(8); PG8_WAIT_L(0); PG8_BAR; PG8_MMA(0, 0, At, B0); PG8_MMA(0, 1, At, B1); PG8_BAR; PG8_SCHED;
            PG8_LDA(At, 0, 1); PG8_STAGE(PG8_SB(0, 0), b2, voffB); PG8_STAGE(PG8_SB(0, 1), b2 + hstepB, voffB); PG8_STAGE(PG8_SA(0, 0), a2, voffA);
            PG8_WAIT_V(8); PG8_WAIT_L(0); PG8_BAR; PG8_MMA(1, 0, At, B0); PG8_MMA(1, 1, At, B1); PG8_BAR; PG8_SCHED;
            PG8_LDB(B0, 1, 0); PG8_LDB(B1, 1, 1); PG8_SCHED; PG8_LDA(At, 1, 0); PG8_STAGE(PG8_SA(0, 1), a2 + hstepA, voffA);
            PG8_WAIT_V(8); PG8_WAIT_L(0); PG8_BAR; PG8_MMA(0, 0, At, B0); PG8_MMA(0, 1, At, B1); PG8_BAR; PG8_SCHED;
            PG8_LDA(At, 1, 1); PG8_STAGE(PG8_SB(1, 0), b3, voffB); PG8_STAGE(PG8_SB(1, 1), b3 + hstepB, voffB); PG8_STAGE(PG8_SA(1, 0), a3, voffA);
            PG8_WAIT_V(8); PG8_WAIT_L(0); PG8_BAR; PG8_MMA(1, 0, At, B0); PG8_MMA(1, 1, At, B1); PG8_BAR; PG8_SCHED;
        }
        if (wr == 0) PG8_BAR;
        if constexpr (!Epi::AFTER_DRAIN) E(acc, cur, wr, wc, fr, fq);
        if (!has_next) break;
#pragma unroll
        for (int a = 0; a < 2; ++a)
#pragma unroll
            for (int b = 0; b < 2; ++b)
#pragma unroll
                for (int m = 0; m < 4; ++m)
#pragma unroll
                    for (int n = 0; n < 2; ++n) acc[a][b][m][n] = (f32x4){0.f, 0.f, 0.f, 0.f};
        cur = nxt; cA = nA; cB = nB; ++ui;
        if (wr == 1) PG8_BAR;
    }
    PG8_WAIT_V(0);
    PG8_BAR;
    if constexpr (Epi::AFTER_DRAIN) E.fused(acc, cur, wr, wc, fr, fq, lds, wid, lane);
#undef PG8_SA
#undef PG8_SB
#undef PG8_STAGE
#undef PG8_LDA
#undef PG8_LDB
#undef PG8_MMA
#undef PG8_WAIT_V
#undef PG8_WAIT_L
#undef PG8_BAR
#undef PG8_SCHED
}
}

struct Args {
    const float *x, *c, *ctx, *c_ctx, *ada_w, *ada_b, *norm_mix_g, *norm_ffn_g, *final_g, *conv_w_in, *conv_k, *conv_w_out, *attn_w_qkv, *attn_qg, *attn_kg,
        *attn_w_out, *ret_w_in, *ret_decay, *ret_w_out, *ffn_w_up, *ffn_conv_k, *ffn_conv_b, *ffn_w_down;
    float* out; unsigned char* ws;
    int ph_lo, ph_hi, coop, pad;
};

__device__ __forceinline__ unsigned f2bf(float f) { unsigned u = __builtin_bit_cast(unsigned, f); return (u + 0x7fffu + ((u >> 16) & 1u)) >> 16; }
__device__ __forceinline__ unsigned pk2(float lo, float hi) { return f2bf(lo) | (f2bf(hi) << 16); }
__device__ __forceinline__ void transpose_item(const float* W, int K, int N, bf16_t* WT, LAS float* scr, int item, int lane) {
    const int nblk = N / 32, kb = item / nblk, nb = item % nblk, k0 = 64 * kb, n0 = 32 * nb;
    float wv[32];
#pragma unroll
    for (int i = 0; i < 32; ++i) wv[i] = W[(size_t)(k0 + 2 * i + (lane >> 5)) * N + n0 + (lane & 31)];
#pragma unroll
    for (int i = 0; i < 32; ++i) scr[(2 * i + (lane >> 5)) * 33 + (lane & 31)] = wv[i];
    asm volatile("s_waitcnt lgkmcnt(0)" ::: "memory");
    const int c = lane & 7;
#pragma unroll
    for (int j = 0; j < 4; ++j) { const int n = (lane >> 3) + 8 * j; const LAS float* s = scr + (8 * c) * 33 + n;
        u32x4 o; o.x = pk2(s[0 * 33], s[1 * 33]); o.y = pk2(s[2 * 33], s[3 * 33]); o.z = pk2(s[4 * 33], s[5 * 33]); o.w = pk2(s[6 * 33], s[7 * 33]);
        *(u32x4*)(WT + (size_t)(n0 + n) * K + k0 + 8 * c) = o; }
    asm volatile("s_waitcnt lgkmcnt(0)" ::: "memory");
}

__device__ __forceinline__ void transpose_flat(const __attribute__((address_space(4))) Args& a, LAS float* scr, int it, int lane) {
    unsigned char* ws = a.ws;
    const float* W; int K, N; bf16_t* WT;
    if (it < 3072) { const int mi = it / 1536; it -= mi * 1536; W = a.conv_w_in + (size_t)mi * D * 3072; K = D; N = 3072; WT = (bf16_t*)(ws + WS_CIN) + (size_t)mi * 3072 * D; }
    else if (it < 4096) { it -= 3072; const int mi = it / 512; it -= mi * 512; W = a.conv_w_out + (size_t)mi * D * D; K = D; N = D; WT = (bf16_t*)(ws + WS_COUT) + (size_t)mi * D * D; }
    else if (it < 4864) { it -= 4096; W = a.attn_w_qkv; K = D; N = 1536; WT = (bf16_t*)(ws + WS_AQKV); }
    else if (it < 5376) { it -= 4864; W = a.attn_w_out; K = D; N = D; WT = (bf16_t*)(ws + WS_AOUT); }
    else if (it < 8448) { it -= 5376; W = a.ret_w_in; K = D; N = 6144; WT = (bf16_t*)(ws + WS_RIN); }
    else if (it < 9472) { it -= 8448; W = a.ret_w_out; K = 2048; N = D; WT = (bf16_t*)(ws + WS_ROUT); }
    else if (it < 20736) { it -= 9472; const int mi = it / 2816; it -= mi * 2816; W = a.ffn_w_up + (size_t)mi * D * DFF2; K = D; N = DFF2; WT = (bf16_t*)(ws + WS_UP) + (size_t)mi * DFF2 * D; }
    else { it -= 20736; const int mi = it / 1408; it -= mi * 1408; W = a.ffn_w_down + (size_t)mi * DFF * D; K = DFF; N = D; WT = (bf16_t*)(ws + WS_DN) + (size_t)mi * D * DFF; }
    transpose_item(W, K, N, WT, scr, it, lane);
}
__device__ __forceinline__ void convert_set(const __attribute__((address_space(4))) Args& a, ldsp lds, int set, int w, int nw, int wave, int lane) {
    LAS float* scr = (LAS float*)(lds + wave * 8704);
    int s0, l0, s1, l1, s2, l2, s3, l3, s4, l4;
    if (set == 0) { s0 = 0; l0 = 1536; s1 = 3072; l1 = 512; s2 = 9472; l2 = 2816; s3 = 20736; l3 = 1408; s4 = 0; l4 = 0; }
    else if (set == 1) { s0 = 4096; l0 = 1280; s1 = 12288; l1 = 2816; s2 = 0; l2 = 0; s3 = 0; l3 = 0; s4 = 0; l4 = 0; }
    else if (set == 2) { s0 = 22144; l0 = 1408; s1 = 5376; l1 = 4096; s2 = 15104; l2 = 2816; s3 = 0; l3 = 0; s4 = 0; l4 = 0; }
    else { s0 = 23552; l0 = 1408; s1 = 1536; l1 = 1536; s2 = 3584; l2 = 512; s3 = 17920; l3 = 2816; s4 = 24960; l4 = 1408; }
    const int total = l0 + l1 + l2 + l3 + l4;
    for (int j = w; j < total; j += nw) {
        int r = j, it;
        if (r < l0) it = s0 + r; else { r -= l0;
            if (r < l1) it = s1 + r; else { r -= l1;
                if (r < l2) it = s2 + r; else { r -= l2;
                    if (r < l3) it = s3 + r; else it = s4 + (r - l3); } } }
        transpose_flat(a, scr, it, lane);
    }
}
__device__ __forceinline__ void prologue(const __attribute__((address_space(4))) Args& a, ldsp lds, int gw, int NGW, int wave, int lane, const int tid, const int bid, const int G) {
    LAS float* scr = (LAS float*)(lds + wave * 8704);
    unsigned char* ws = a.ws;
    convert_set(a, lds, 0, gw, NGW, wave, lane);
    if (G != 256) { for (int cs = 1; cs < 4; ++cs) convert_set(a, lds, cs, gw, NGW, wave, lane); }
    { const f32x4* src = (const f32x4*)a.ctx; f32x4* dst = (f32x4*)(ws + WS_XC); for (int i = gw * 64 + lane; i < MC * D / 4; i += NGW * 64) dst[i] = src[i]; }
    if (bid == 0 && tid < 8) ((float*)(ws + WS_MODS))[4 * 9 * NMOD + tid] = __builtin_amdgcn_logf(1.0f - __builtin_amdgcn_exp2f(-a.ret_decay[tid]));
    __syncthreads();
    LAS float* sc = (LAS float*)(lds + 69632);
    LAS float* red = (LAS float*)(lds + 106496);
    for (int i = tid; i < 9 * D; i += 512) { const float v = (i < 8 * D) ? a.c[i] : a.c_ctx[i - 8 * D]; sc[i] = silu_f(v); }
    __syncthreads();
    float* mods = (float*)(ws + WS_MODS);
    for (int u = bid; u < 4 * 96; u += G) {
        const int layer = u / 96, col0 = (u % 96) * 64;
        const float* Wl = a.ada_w + (size_t)layer * D * NMOD + col0 + lane;
        float acc[9];
#pragma unroll
        for (int j = 0; j < 9; ++j) acc[j] = 0.f;
        for (int k = wave * 128; k < wave * 128 + 128; k += 16) {
            float wv[16];
#pragma unroll
            for (int q = 0; q < 16; ++q) wv[q] = Wl[(size_t)(k + q) * NMOD];
#pragma unroll
            for (int q4 = 0; q4 < 4; ++q4)
#pragma unroll
                for (int j = 0; j < 9; ++j) { const f32x4 s4 = *(const LAS f32x4*)(sc + j * D + k + 4 * q4); acc[j] += s4[0] * wv[4 * q4] + s4[1] * wv[4 * q4 + 1] + s4[2] * wv[4 * q4 + 2] + s4[3] * wv[4 * q4 + 3]; }
        }
#pragma unroll
        for (int j = 0; j < 9; ++j) red[(wave * 9 + j) * 64 + lane] = acc[j];
        __syncthreads();
        for (int i = tid; i < 9 * 64; i += 512) { const int j = i >> 6, cc = i & 63; float s = a.ada_b[layer * NMOD + col0 + cc];
#pragma unroll
            for (int w = 0; w < 8; ++w) s += red[(w * 9 + j) * 64 + cc];
            mods[((size_t)layer * 9 + j) * NMOD + col0 + cc] = s; }
        __syncthreads();
    }
}

__device__ __forceinline__ void norm_phase(const float* xs_lat, const float* xs_ctx, const float* partA, const float* partB, float* xc_wr, int row_begin, int rows, const float* gain, const float* modl, int shoff, int scoff, bf16_t* H, int gw, int NGW, int lane) {
    for (int row0 = row_begin + gw; row0 < rows; row0 += 2 * NGW) {
        f32x4 v[2][4]; bool ok[2], latv[2];
#pragma unroll
        for (int u = 0; u < 2; ++u) { const int row = row0 + u * NGW; ok[u] = row < rows; const bool lat = row < ML; latv[u] = lat;
            if (ok[u]) { const f32x4* xr = (const f32x4*)(lat ? xs_lat + (size_t)row * D : xs_ctx + (size_t)(row - ML) * D) + lane;
#pragma unroll
                for (int j = 0; j < 4; ++j) v[u][j] = xr[64 * j]; } }
#pragma unroll
        for (int u = 0; u < 2; ++u) if (ok[u]) {
            const int row = row0 + u * NGW; const bool lat = latv[u]; const int b = lat ? (row >> 11) : NB;
            if (!lat && partA != nullptr) {
                const size_t ro = (size_t)(row - ML) * D;
#pragma unroll
                for (int j = 0; j < 4; ++j) { const int ix = 64 * j + lane;
                    v[u][j] = (((v[u][j] + ((const f32x4*)(partA + ro))[ix]) + ((const f32x4*)(partA + (size_t)MC * D + ro))[ix]) + ((const f32x4*)(partB + ro))[ix]) + ((const f32x4*)(partB + (size_t)MC * D + ro))[ix];
                    ((f32x4*)(xc_wr + ro))[ix] = v[u][j]; }
            }
            float s = 0.f;
#pragma unroll
            for (int j = 0; j < 4; ++j) s += (v[u][j][0] * v[u][j][0] + v[u][j][1] * v[u][j][1]) + (v[u][j][2] * v[u][j][2] + v[u][j][3] * v[u][j][3]);
            const float rstd = 1.0f / sqrtf(wave_sum(s) * (1.f / D) + EPS);
            const float* mb = modl + (size_t)b * NMOD;
            u32x2* o8 = (u32x2*)(H + (size_t)row * D) + lane;
#pragma unroll
            for (int j = 0; j < 4; ++j) { const int c = 4 * (lane + 64 * j);
                const f32x4 g4 = *(const f32x4*)(gain + c), sc4 = *(const f32x4*)(mb + scoff + c), sh4 = *(const f32x4*)(mb + shoff + c);
                const f32x4 y = (v[u][j] * rstd * g4) * (sc4 + 1.0f) + sh4;
                u32x2 w; w.x = cvt_pk_bf16(y[0], y[1]); w.y = cvt_pk_bf16(y[2], y[3]); o8[64 * j] = w; }
        }
    }
}
__device__ __forceinline__ void final_phase(float* x, const float* gain, int gw, int NGW, int lane) {
    for (int row0 = gw; row0 < ML; row0 += 2 * NGW) {
        f32x4 v[2][4];
#pragma unroll
        for (int u = 0; u < 2; ++u) { const f32x4* xr = (const f32x4*)(x + (size_t)(row0 + u * NGW) * D) + lane;
#pragma unroll
            for (int j = 0; j < 4; ++j) v[u][j] = xr[64 * j]; }
#pragma unroll
        for (int u = 0; u < 2; ++u) { f32x4* xr = (f32x4*)(x + (size_t)(row0 + u * NGW) * D) + lane; float s = 0.f;
#pragma unroll
            for (int j = 0; j < 4; ++j) s += (v[u][j][0] * v[u][j][0] + v[u][j][1] * v[u][j][1]) + (v[u][j][2] * v[u][j][2] + v[u][j][3] * v[u][j][3]);
            const float rstd = 1.0f / sqrtf(wave_sum(s) * (1.f / D) + EPS);
#pragma unroll
            for (int j = 0; j < 4; ++j) { const f32x4 g4 = *(const f32x4*)(gain + 4 * (lane + 64 * j)); xr[64 * j] = v[u][j] * rstd * g4; } }
    }
}
__device__ __forceinline__ void convgate_phase(const bf16_t* U, bf16_t* H, int rows, const float* ck, int gw, int NGW, int lane) {
    for (int row = gw; row < rows; row += NGW) {
        const bool lat = row < ML; const int t = lat ? (row & (SEQ - 1)) : ((row - ML) & (CL - 1)); const int L = lat ? SEQ : CL;
        const bool hasp = t > 0, hasn = t < L - 1;
        const bf16_t* ur = U + (size_t)row * 3072;
        u32x4 bq[2], cq[2], vq[2], cp[2], vp[2], cn[2], vn[2];
#pragma unroll
        for (int hf = 0; hf < 2; ++hf) {
            const int c0 = lane * 16 + hf * 8;
            bq[hf] = *(const u32x4*)(ur + c0); cq[hf] = *(const u32x4*)(ur + 1024 + c0); vq[hf] = *(const u32x4*)(ur + 2048 + c0);
            cp[hf] = (u32x4){0, 0, 0, 0}; vp[hf] = cp[hf]; cn[hf] = cp[hf]; vn[hf] = cp[hf];
            if (hasp) { cp[hf] = *(const u32x4*)(ur - 3072 + 1024 + c0); vp[hf] = *(const u32x4*)(ur - 3072 + 2048 + c0); }
            if (hasn) { cn[hf] = *(const u32x4*)(ur + 3072 + 1024 + c0); vn[hf] = *(const u32x4*)(ur + 3072 + 2048 + c0); }
        }
#pragma unroll
        for (int hf = 0; hf < 2; ++hf) {
            const int c0 = lane * 16 + hf * 8;
            u32x4 ow;
#pragma unroll
            for (int e = 0; e < 4; ++e) {
                const f32x2 w0 = *(const f32x2*)(ck + c0 + 2 * e), w1 = *(const f32x2*)(ck + D + c0 + 2 * e), w2 = *(const f32x2*)(ck + 2 * D + c0 + 2 * e);
                const float lo = bflo(bq[hf][e]) * (w0[0] * (bflo(cp[hf][e]) * bflo(vp[hf][e])) + w1[0] * (bflo(cq[hf][e]) * bflo(vq[hf][e])) + w2[0] * (bflo(cn[hf][e]) * bflo(vn[hf][e])));
                const float hi = bfhi(bq[hf][e]) * (w0[1] * (bfhi(cp[hf][e]) * bfhi(vp[hf][e])) + w1[1] * (bfhi(cq[hf][e]) * bfhi(vq[hf][e])) + w2[1] * (bfhi(cn[hf][e]) * bfhi(vn[hf][e])));
                ow[e] = cvt_pk_bf16(lo, hi);
            }
            *(u32x4*)(H + (size_t)row * D + c0) = ow;
        }
    }
}
__device__ __forceinline__ void ffngate_a(const bf16_t* U, bf16_t* SIDE, int rows, int gtid, int NTH) {
    const int n = (rows / 32) * 2 * 704;
    for (int i = gtid; i < n; i += NTH) { const int c8 = i % 704, cw = i / 704, row = 32 * (cw >> 1) + ((cw & 1) ? 31 : 0);
        *(u32x4*)(SIDE + (size_t)cw * DFF2 + c8 * 8) = *(const u32x4*)(U + (size_t)row * DFF2 + c8 * 8); }
}
__device__ __forceinline__ void ffngate_b(bf16_t* U, bf16_t* DST, size_t dmask, const bf16_t* SIDE, int rows, const float* fk, const float* fb, int gw, int NGW, int lane) {
    const int ntask = (rows / 32) * 11;
    for (int wt = gw; wt < ntask; wt += NGW) {
        const int c = wt / 11, s = wt % 11, ch = 256 * s + 4 * lane, r0 = 32 * c;
        const bool lat = r0 < ML; const int t0 = lat ? (r0 & (SEQ - 1)) : ((r0 - ML) & (CL - 1)); const int L = lat ? SEQ : CL;
        const bool first = (t0 == 0), lastc = (t0 + 32 == L);
        const f32x4 kv0 = *(const f32x4*)(fk + ch), kv1 = *(const f32x4*)(fk + DFF2 + ch), kv2 = *(const f32x4*)(fk + 2 * DFF2 + ch);
        const f32x4 kg0 = *(const f32x4*)(fk + DFF + ch), kg1 = *(const f32x4*)(fk + DFF2 + DFF + ch), kg2 = *(const f32x4*)(fk + 2 * DFF2 + DFF + ch);
        const f32x4 bv = *(const f32x4*)(fb + ch), bg = *(const f32x4*)(fb + DFF + ch);
        f32x4 pv = (f32x4){0.f, 0.f, 0.f, 0.f}, pg = pv, cv, cgt;
        if (!first) { const bf16_t* sp = SIDE + (size_t)((c - 1) * 2 + 1) * DFF2 + ch; const u32x2 a = *(const u32x2*)sp, b = *(const u32x2*)(sp + DFF);
            pv = (f32x4){bflo(a.x), bfhi(a.x), bflo(a.y), bfhi(a.y)}; pg = (f32x4){bflo(b.x), bfhi(b.x), bflo(b.y), bfhi(b.y)}; }
        { const bf16_t* up = U + (size_t)r0 * DFF2 + ch; const u32x2 a = *(const u32x2*)up, b = *(const u32x2*)(up + DFF);
            cv = (f32x4){bflo(a.x), bfhi(a.x), bflo(a.y), bfhi(a.y)}; cgt = (f32x4){bflo(b.x), bfhi(b.x), bflo(b.y), bfhi(b.y)}; }
        for (int rb = 0; rb < 4; ++rb) {
            u32x2 nv[8], ng[8];
#pragma unroll
            for (int i = 0; i < 8; ++i) { const int rr = 8 * rb + i + 1;
                const bf16_t* p = (rr < 32) ? U + (size_t)(r0 + rr) * DFF2 + ch : SIDE + (size_t)((lastc ? c : c + 1) * 2) * DFF2 + ch;
                nv[i] = *(const u32x2*)p; ng[i] = *(const u32x2*)(p + DFF); }
#pragma unroll
            for (int i = 0; i < 8; ++i) { const int rr = 8 * rb + i + 1;
                f32x4 xv = (f32x4){bflo(nv[i].x), bfhi(nv[i].x), bflo(nv[i].y), bfhi(nv[i].y)}, xg = (f32x4){bflo(ng[i].x), bfhi(ng[i].x), bflo(ng[i].y), bfhi(ng[i].y)};
                if (rr == 32 && lastc) { xv = (f32x4){0.f, 0.f, 0.f, 0.f}; xg = xv; }
                const f32x4 val = kv0 * pv + kv1 * cv + kv2 * xv + bv, gt = kg0 * pg + kg1 * cgt + kg2 * xg + bg;
                u32x2 w; w.x = cvt_pk_bf16(silu_f(gt[0]) * val[0], silu_f(gt[1]) * val[1]); w.y = cvt_pk_bf16(silu_f(gt[2]) * val[2], silu_f(gt[3]) * val[3]);
                *(u32x2*)(DST + (((size_t)(r0 + rr - 1) * DFF2 + ch) & dmask)) = w;
                pv = cv; pg = cgt; cv = xv; cgt = xg; }
        }
    }
}
__device__ __forceinline__ void ffngate_fix(bf16_t* A2, const bf16_t* side, int rows, const float* fk, const float* fb, int gw, int NGW, int lane) {
    const int ntask = (rows / 64) * 2 * 11;
    for (int wt = gw; wt < ntask; wt += NGW) {
        const int s = wt % 11, sw = wt / 11, last = sw & 1, G = sw >> 1, ch = 256 * s + 4 * lane;
        const int R = 64 * G + (last ? 63 : 0);
        const bool lat = R < ML; const int t = lat ? (R & (SEQ - 1)) : ((R - ML) & (CL - 1)); const int L = lat ? SEQ : CL;
        const bool hasp = t > 0, hasn = t < L - 1;
        const bf16_t* pc = side + (size_t)(G * 4 + (last ? 3 : 0)) * DFF2 + ch;
        const bf16_t* pp = last ? side + (size_t)(G * 4 + 2) * DFF2 + ch : side + (size_t)((G - 1) * 4 + 3) * DFF2 + ch;
        const bf16_t* pn = last ? side + (size_t)((G + 1) * 4 + 0) * DFF2 + ch : side + (size_t)(G * 4 + 1) * DFF2 + ch;
        u32x2 cv = *(const u32x2*)pc, cg = *(const u32x2*)(pc + DFF), pv = (u32x2){0u, 0u}, pg = pv, nv = pv, ng = pv;
        if (hasp) { pv = *(const u32x2*)pp; pg = *(const u32x2*)(pp + DFF); }
        if (hasn) { nv = *(const u32x2*)pn; ng = *(const u32x2*)(pn + DFF); }
        const f32x4 kv0 = *(const f32x4*)(fk + ch), kv1 = *(const f32x4*)(fk + DFF2 + ch), kv2 = *(const f32x4*)(fk + 2 * DFF2 + ch), bv = *(const f32x4*)(fb + ch);
        const f32x4 kg0 = *(const f32x4*)(fk + DFF + ch), kg1 = *(const f32x4*)(fk + DFF2 + DFF + ch), kg2 = *(const f32x4*)(fk + 2 * DFF2 + DFF + ch), bg = *(const f32x4*)(fb + DFF + ch);
#define UNP(w) (f32x4){bflo((w).x), bfhi((w).x), bflo((w).y), bfhi((w).y)}
        const f32x4 val = kv0 * UNP(pv) + kv1 * UNP(cv) + kv2 * UNP(nv) + bv, gt = kg0 * UNP(pg) + kg1 * UNP(cg) + kg2 * UNP(ng) + bg;
#undef UNP
        u32x2 w; w.x = cvt_pk_bf16(silu_f(gt[0]) * val[0], silu_f(gt[1]) * val[1]); w.y = cvt_pk_bf16(silu_f(gt[2]) * val[2], silu_f(gt[3]) * val[3]);
        *(u32x2*)(A2 + (size_t)R * DFF + ch) = w;
    }
}
__device__ __forceinline__ void attnprep_phase(bf16_t* QKV, const float* qg, const float* kg, int gw, int NGW, int lane) {
    for (int row = gw; row < MT; row += NGW) {
        const bool lat = row < ML; const int t = row & (SEQ - 1);
        const float pos = (lane & 2) ? (float)(t & 63) : (float)(t >> 6);
#pragma unroll
        for (int part = 0; part < 2; ++part) {
            const bool act = part == 0 || lane < 16;
            bf16_t* p = QKV + (size_t)row * 1536 + (part ? 1024 : 0) + (act ? lane * 16 : 0);
            const u32x4 r0 = *(const u32x4*)p, r1 = *(const u32x4*)(p + 8);
            float v[16];
#pragma unroll
            for (int e = 0; e < 4; ++e) { v[2 * e] = bflo(r0[e]); v[2 * e + 1] = bfhi(r0[e]); v[8 + 2 * e] = bflo(r1[e]); v[8 + 2 * e + 1] = bfhi(r1[e]); }
            float ss = 0.f;
#pragma unroll
            for (int e = 0; e < 16; ++e) ss += v[e] * v[e];
            ss += __shfl_xor(ss, 1); ss += __shfl_xor(ss, 2);
            const float rstd = 1.0f / sqrtf(ss * (1.f / 64.f) + EPS);
            const float* gp = (part ? kg : qg) + (lane & 3) * 16;
            const float osc = part ? 1.0f : C2;
            u32x4 o0, o1;
#pragma unroll
            for (int e = 0; e < 16; e += 2) {
                float y[2];
#pragma unroll
                for (int q = 0; q < 2; ++q) {
                    const float mine = v[e + q] * rstd * gp[e + q];
                    const float other = __shfl_xor(mine, 1);
                    float r = mine;
                    if (lat) {
                        const float ang = pos * __builtin_amdgcn_exp2f(-(float)(e + q) * (LOG2_THETA / 16.f));
                        float tr = ang * INV_2PI; tr -= rintf(tr);
                        const float sn = __builtin_amdgcn_sinf(tr), cs = __builtin_amdgcn_cosf(tr);
                        r = (lane & 1) ? (other * sn + mine * cs) : (mine * cs - other * sn);
                    }
                    y[q] = r * osc;
                }
                const unsigned w = cvt_pk_bf16(y[0], y[1]);
                if (e < 8) o0[e >> 1] = w; else o1[(e - 8) >> 1] = w;
            }
            if (act) { *(u32x4*)p = o0; *(u32x4*)(p + 8) = o1; }
        }
    }
}
__device__ __forceinline__ void retprep_phase(bf16_t* R, bf16_t* RC, int gw, int NGW, int lane) {
    for (int row = gw; row < MT; row += NGW) {
        const bool lat = row < ML;
        if (lat) {
            const int t = row & (SEQ - 1);
            const float pos = (lane & 8) ? (float)(t & 63) : (float)(t >> 6);
#pragma unroll
            for (int part = 0; part < 2; ++part) {
                bf16_t* p = R + (size_t)row * 6144 + part * 1024 + lane * 16;
                const u32x4 r0 = *(const u32x4*)p, r1 = *(const u32x4*)(p + 8);
                float v[16];
#pragma unroll
                for (int e = 0; e < 4; ++e) { v[2 * e] = bflo(r0[e]); v[2 * e + 1] = bfhi(r0[e]); v[8 + 2 * e] = bflo(r1[e]); v[8 + 2 * e + 1] = bfhi(r1[e]); }
                const float osc = part ? 0.0625f : 1.0f;
                u32x4 o0, o1;
#pragma unroll
                for (int e = 0; e < 16; e += 2) {
                    float y[2];
#pragma unroll
                    for (int q = 0; q < 2; ++q) {
                        const float mine = v[e + q];
                        const float other = __shfl_xor(mine, 4);
                        const float ang = pos * __builtin_amdgcn_exp2f(-(float)((lane & 3) * 16 + e + q) * (LOG2_THETA / 64.f));
                        float tr = ang * INV_2PI; tr -= rintf(tr);
                        const float sn = __builtin_amdgcn_sinf(tr), cs = __builtin_amdgcn_cosf(tr);
                        y[q] = ((lane & 4) ? (other * sn + mine * cs) : (mine * cs - other * sn)) * osc;
                    }
                    const unsigned w = cvt_pk_bf16(y[0], y[1]);
                    if (e < 8) o0[e >> 1] = w; else o1[(e - 8) >> 1] = w;
                }
                *(u32x4*)p = o0; *(u32x4*)(p + 8) = o1;
            }
        } else {
            bf16_t* p = RC + (size_t)(row - ML) * 3072 + lane * 16;
            const u32x4 r0 = *(const u32x4*)p, r1 = *(const u32x4*)(p + 8);
            u32x4 o0, o1;
#pragma unroll
            for (int e = 0; e < 4; ++e) { o0[e] = cvt_pk_bf16(bflo(r0[e]) * 0.0625f, bfhi(r0[e]) * 0.0625f); o1[e] = cvt_pk_bf16(bflo(r1[e]) * 0.0625f, bfhi(r1[e]) * 0.0625f); }
            *(u32x4*)p = o0; *(u32x4*)(p + 8) = o1;
        }
    }
}

namespace attn_body {
using bf16=__hip_bfloat16;
using bf16x8=__attribute__((ext_vector_type(8)))short;
using s16x4=__attribute__((ext_vector_type(4)))short;
using f32x16=__attribute__((ext_vector_type(16)))float;
using u32x4=__attribute__((ext_vector_type(4)))unsigned;
constexpr int D=64,QP=1536,OP=1024;
constexpr int NW=8,QBLK=32,QB=QBLK*NW,KVBLK=64;
__device__ __forceinline__ int crow(int r,int hi){return (r&3)+8*(r>>2)+4*hi;}
#define SBAR() __builtin_amdgcn_sched_barrier(0)
constexpr int NSLOT=3, SLOTB=8192;
constexpr int LDS_K=0, LDS_V=NSLOT*SLOTB, LDS_WS=2*NSLOT*SLOTB, LDS_OST=LDS_WS+NW*64*4, LDS_BYTES=LDS_OST+NW*4096;
constexpr float C2=0.125f*1.4426950408889634f;
__device__ __forceinline__ void glds16(const void*gsrc,unsigned lds_dst){unsigned keep;
  asm volatile("s_mov_b32 %0, m0\n\ts_mov_b32 m0, %2\n\ts_nop 0\n\tglobal_load_lds_dwordx4 %1, off\n\ts_mov_b32 m0, %0":"=&s"(keep):"v"(gsrc),"s"(lds_dst):"memory");}
__device__ __forceinline__ float max3f(float a,float b,float c){float r;asm("v_max3_f32 %0, %1, %2, %3":"=v"(r):"v"(a),"v"(b),"v"(c));return r;}
__device__ __forceinline__ float max2f(float a,float b){float r;asm("v_max_f32_e32 %0, %1, %2":"=v"(r):"v"(a),"v"(b));return r;}
__device__ __forceinline__ float fadd_s(float a,float b){float r;asm("v_add_f32_e32 %0, %1, %2":"=v"(r):"v"(a),"v"(b));return r;}
__device__ __forceinline__ float fsub_s(float a,float b){float r;asm("v_sub_f32_e32 %0, %1, %2":"=v"(r):"v"(a),"v"(b));return r;}
typedef float f32x2_t __attribute__((ext_vector_type(2))); typedef __bf16 bf16x2_t __attribute__((ext_vector_type(2)));
__device__ __forceinline__ unsigned cvtpk_s(float lo,float hi){f32x2_t v={lo,hi};bf16x2_t b=__builtin_convertvector(v,bf16x2_t);return __builtin_bit_cast(unsigned,b);}
#define WAIT_BAR(N) asm volatile("s_waitcnt vmcnt(" #N ") lgkmcnt(0)\n\ts_barrier":::"memory")

__device__ __forceinline__ void qkt(f32x16&p0,f32x16&p1,const char*Kslot,const bf16x8*qr,const f32x16&negm,int r32,int hi){
  const char*kb=Kslot+hi*1024+r32*16;
  #pragma unroll
  for(int d0=0;d0<4;++d0){
    const bf16x8 b0=*reinterpret_cast<const bf16x8*>(kb+d0*2048);
    const bf16x8 b1=*reinterpret_cast<const bf16x8*>(kb+d0*2048+512);
    if(d0==0){p0=__builtin_amdgcn_mfma_f32_32x32x16_bf16(b0,qr[0],negm,0,0,0);p1=__builtin_amdgcn_mfma_f32_32x32x16_bf16(b1,qr[0],negm,0,0,0);}
    else{p0=__builtin_amdgcn_mfma_f32_32x32x16_bf16(b0,qr[d0],p0,0,0,0);p1=__builtin_amdgcn_mfma_f32_32x32x16_bf16(b1,qr[d0],p1,0,0,0);}}
}
typedef __attribute__((address_space(3))) const char* lds_cptr;
typedef short v4i16_t __attribute__((ext_vector_type(4)));
__device__ __forceinline__ void kload8(bf16x8*kf,lds_cptr kp){
  kf[0]=*(const __attribute__((address_space(3))) bf16x8*)(kp);      kf[1]=*(const __attribute__((address_space(3))) bf16x8*)(kp+512);
  kf[2]=*(const __attribute__((address_space(3))) bf16x8*)(kp+2048); kf[3]=*(const __attribute__((address_space(3))) bf16x8*)(kp+2560);
  kf[4]=*(const __attribute__((address_space(3))) bf16x8*)(kp+4096); kf[5]=*(const __attribute__((address_space(3))) bf16x8*)(kp+4608);
  kf[6]=*(const __attribute__((address_space(3))) bf16x8*)(kp+6144); kf[7]=*(const __attribute__((address_space(3))) bf16x8*)(kp+6656);
}
__device__ __forceinline__ void kload2(bf16x8*kf,lds_cptr kp,int j){ kf[2*j]=*(const __attribute__((address_space(3))) bf16x8*)(kp+j*2048); kf[2*j+1]=*(const __attribute__((address_space(3))) bf16x8*)(kp+j*2048+512); }
__device__ __forceinline__ s16x4 vtr(lds_cptr p){ return __builtin_bit_cast(s16x4,__builtin_amdgcn_ds_read_tr16_b64_v4i16((__attribute__((address_space(3))) v4i16_t*)p)); }
__device__ __forceinline__ float rowmax(const f32x16&p0,const f32x16&p1){
  float a=max3f(p0[0],p0[1],p1[0]),b=max3f(p0[2],p0[3],p1[1]);a=max3f(a,p1[2],p1[3]);
  #pragma unroll
  for(int r=4;r<16;r+=4){a=max3f(a,p0[r],p0[r+1]);b=max3f(b,p0[r+2],p0[r+3]);a=max3f(a,p1[r],p1[r+1]);b=max3f(b,p1[r+2],p1[r+3]);}
  const float m=max2f(a,b);
  auto rr=__builtin_amdgcn_permlane32_swap(__float_as_uint(m),__float_as_uint(m),false,false);
  return max2f(__uint_as_float(rr[0]),__uint_as_float(rr[1]));
}
__device__ __forceinline__ void pv(f32x16*o,int vb,bf16x8 pa0,bf16x8 pa1,bf16x8 pa2,bf16x8 pa3){
  #pragma unroll
  for(int d0=0;d0<2;++d0){s16x4 lo[4],hi[4];
    #pragma unroll
    for(int ks=0;ks<4;++ks){
      asm volatile("ds_read_b64_tr_b16 %0,%1 offset:%c2":"=&v"(lo[ks]):"v"(vb),"i"(d0*4096+ks*1024):"memory");
      asm volatile("ds_read_b64_tr_b16 %0,%1 offset:%c2":"=&v"(hi[ks]):"v"(vb),"i"(d0*4096+ks*1024+512):"memory");}
    asm volatile("s_waitcnt lgkmcnt(0)":::"memory");SBAR();
    #define PK(k) (bf16x8){lo[k][0],lo[k][1],lo[k][2],lo[k][3],hi[k][0],hi[k][1],hi[k][2],hi[k][3]}
    o[d0]=__builtin_amdgcn_mfma_f32_32x32x16_bf16(pa0,PK(0),o[d0],0,0,0);
    o[d0]=__builtin_amdgcn_mfma_f32_32x32x16_bf16(pa1,PK(1),o[d0],0,0,0);
    o[d0]=__builtin_amdgcn_mfma_f32_32x32x16_bf16(pa2,PK(2),o[d0],0,0,0);
    o[d0]=__builtin_amdgcn_mfma_f32_32x32x16_bf16(pa3,PK(3),o[d0],0,0,0);
    #undef PK
  }
}

#ifndef ATTN_STORE16
#define ATTN_STORE16(p,v) (*(u32x4*)(p)=(v))
#endif
template<int THRL> __device__ __forceinline__ void attn_unit(const bf16*Qw0,const bf16*__restrict__ Kcol,int latrow0,int nlat,int ctxrow0,int NT,bf16*Ow0,char*shm,const int tid){
  const int lane=tid&63,r32=lane&31,hi=lane>>5; const int wid=__builtin_amdgcn_readfirstlane(tid>>6);
  const bf16*Qw=Qw0+(long)(wid*QBLK)*QP;
  const unsigned lds0=(unsigned)(uintptr_t)shm;
  float*wsf=(float*)(shm+LDS_WS)+wid*64;
  const bf16*ksrc=Kcol+(long)lane*QP+wid*8;
  const bf16*vsrc=Kcol+256+(long)(16*(wid&3)+(lane>>2))*QP+(wid>>2)*32+(lane&3)*8;
  #define TROW(t) ((long)(((t)<nlat)?latrow0+64*(t):ctxrow0+64*((t)-nlat))*QP)
  const unsigned kdst=lds0+LDS_K+wid*1024, vdst=lds0+LDS_V+wid*1024;
  #define DMA_K(t,slot) glds16(ksrc+TROW(t),(unsigned)__builtin_amdgcn_readfirstlane(kdst+(slot)))
  #define DMA_V(t,slot) glds16(vsrc+TROW(t),(unsigned)__builtin_amdgcn_readfirstlane(vdst+(slot)))
  const int vb0=(int)(lds0+LDS_V)+((lane>>4)&1)*32+(lane&3)*8+(4*hi+((lane&15)>>2))*64;
  const char*Kbase=shm+LDS_K; bf16x8 kf[8];
  const lds_cptr shm3=(lds_cptr)shm; const lds_cptr kp0=shm3+LDS_K+hi*1024+r32*16; const lds_cptr vp0=shm3+LDS_V+((lane>>4)&1)*32+(lane&3)*8+(4*hi+((lane&15)>>2))*64;
  DMA_K(0,0);DMA_V(0,0);DMA_K(1,SLOTB);
  bf16x8 qr[4];
  #pragma unroll
  for(int d0=0;d0<4;++d0)qr[d0]=*reinterpret_cast<const bf16x8*>(&Qw[(long)r32*QP+d0*16+hi*8]);
  float mhat=0.f,l_reg=0.f;f32x16 o[2];o[0]=f32x16{};o[1]=f32x16{};const f32x16 negm=f32x16{};
  #define CMASK(P0,P1,t) do{}while(0)
  bool resc=false;
  #define START(P0,P1) do{ const float rm=rowmax(P0,P1); resc=false; \
    { const float dl=rm; mhat=fadd_s(mhat,dl); \
      _Pragma("unroll") for(int r=0;r<16;++r){P0[r]=fsub_s(P0[r],dl);P1[r]=fsub_s(P1[r],dl);} } \
    _Pragma("unroll") for(int r=0;r<16;++r)P0[r]=__builtin_amdgcn_exp2f(P0[r]); }while(0)
  #define RESC() do{ if(resc){ asm volatile("s_waitcnt lgkmcnt(0)":::"memory"); \
      _Pragma("unroll") for(int d_=0;d_<2;++d_) _Pragma("unroll") for(int r=0;r<16;++r)o[d_][r]*=wsf[crow(r,hi)]; } }while(0)
  f32x16 pA0,pA1,pB0,pB1;
  int sl_prev=0,sl_cur=0,sl_next=SLOTB;
  #define ROT() do{sl_prev=sl_cur;sl_cur=sl_next;sl_next=(sl_next==(NSLOT-1)*SLOTB)?0:sl_next+SLOTB;}while(0)
  DMA_K(2,2*SLOTB);
  WAIT_BAR(3);
  qkt(pA0,pA1,Kbase,qr,negm,r32,hi);asm volatile("s_nop 15\n\ts_nop 7":"+v"(pA0),"+v"(pA1));CMASK(pA0,pA1,0);
  START(pA0,pA1);
  _Pragma("unroll") for(int r=0;r<16;++r)pA1[r]=__builtin_amdgcn_exp2f(pA1[r]);
  WAIT_BAR(0);
  DMA_K(3,0);DMA_V(1,SLOTB);
  ROT();
  kload8(kf,kp0+sl_cur);
  WAIT_BAR(2);
  s16x4 vlo[8],vhi[8]; u32x4 pw0,pw1,pw2,pw3;
  #define PKW(P,B) cvtpk_s(P[B],P[B+1])
  #define PAF(k) __builtin_bit_cast(bf16x8,pw##k)
  #define VFR(i) (bf16x8){vlo[i][0],vlo[i][1],vlo[i][2],vlo[i][3],vhi[i][0],vhi[i][1],vhi[i][2],vhi[i][3]}
  #define PIN(x) asm volatile("":"+v"(x))
  #define MX3(a,b,c) __builtin_fmaxf(__builtin_fmaxf((a),(b)),(c))
  #define GAPA(MF,A0,A1,A2,A3,W0,W1,PW) do{ MF; sacc+=A0; sacc+=A1; sacc+=A2; sacc+=A3; PIN(sacc); W0; W1; PIN(PW); SBAR(); }while(0)
  #define EX(v) __builtin_amdgcn_exp2f(v)
  #define GAPB(MF,X,B) do{ MF; X[B]=EX(X[B]); X[B+1]=EX(X[B+1]); X[B+2]=EX(X[B+2]); X[B+3]=EX(X[B+3]); PIN(X); SBAR(); }while(0)
  #define VRD(i) do{ vlo[i]=vtr(vp_+(((i)>>2)*4096+((i)&3)*1024)); vhi[i]=vtr(vp_+(((i)>>2)*4096+((i)&3)*1024+512)); }while(0)
  #define KRD(G,j) do{ if(G){ kload2(kf,kp0+sl_next,j); SBAR(); } }while(0)
  #define STEP(C0,C1,P0,P1,t,GK,GV,GL) do{ SBAR(); \
    const lds_cptr vp_=vp0+sl_prev; \
    VRD(0); SBAR(); float sacc=(P0[0]+P0[1]); \
    GAPA(C0=__builtin_amdgcn_mfma_f32_32x32x16_bf16(kf[0],qr[0],negm,0,0,0), P0[2],P0[3],P0[4],P0[5],     pw0[0]=PKW(P0,0), pw0[1]=PKW(P0,2), pw0); \
    VRD(4); SBAR(); GAPA(C1=__builtin_amdgcn_mfma_f32_32x32x16_bf16(kf[1],qr[0],negm,0,0,0), P0[6],P0[7],P0[8],P0[9],     pw0[2]=PKW(P0,4), pw0[3]=PKW(P0,6), pw0); \
    VRD(1); SBAR(); GAPA(C0=__builtin_amdgcn_mfma_f32_32x32x16_bf16(kf[2],qr[1],C0,0,0,0),   P0[10],P0[11],P0[12],P0[13], pw1[0]=PKW(P0,8), pw1[1]=PKW(P0,10), pw1); \
    VRD(5); SBAR(); GAPA(C1=__builtin_amdgcn_mfma_f32_32x32x16_bf16(kf[3],qr[1],C1,0,0,0),   P0[14],P0[15],P1[0],P1[1],   pw1[2]=PKW(P0,12),pw1[3]=PKW(P0,14), pw1); \
    VRD(2); SBAR(); GAPA(C0=__builtin_amdgcn_mfma_f32_32x32x16_bf16(kf[4],qr[2],C0,0,0,0),   P1[2],P1[3],P1[4],P1[5],     pw2[0]=PKW(P1,0), pw2[1]=PKW(P1,2), pw2); \
    VRD(6); SBAR(); GAPA(C1=__builtin_amdgcn_mfma_f32_32x32x16_bf16(kf[5],qr[2],C1,0,0,0),   P1[6],P1[7],P1[8],P1[9],     pw2[2]=PKW(P1,4), pw2[3]=PKW(P1,6), pw2); \
    VRD(3); SBAR(); GAPA(C0=__builtin_amdgcn_mfma_f32_32x32x16_bf16(kf[6],qr[3],C0,0,0,0),   P1[10],P1[11],P1[12],P1[13], pw3[0]=PKW(P1,8), pw3[1]=PKW(P1,10), pw3); \
    VRD(7); SBAR(); GAPA(C1=__builtin_amdgcn_mfma_f32_32x32x16_bf16(kf[7],qr[3],C1,0,0,0),   P1[14],P1[15],0.f,0.f,       pw3[2]=PKW(P1,12),pw3[3]=PKW(P1,14), pw3); \
    l_reg+=sacc; \
    if(GK){DMA_K((t)+3,sl_cur);} if(GV){DMA_V((t)+1,sl_next);} \
    _Pragma("unroll") for(int r=0;r<16;++r){C0[r]-=mhat;C1[r]-=mhat;} \
    { float a=MX3(C0[0],C0[1],C1[0]),b=MX3(C0[2],C0[3],C1[1]); a=MX3(a,C1[2],C1[3]); \
      _Pragma("unroll") for(int r=4;r<16;r+=4){a=MX3(a,C0[r],C0[r+1]);b=MX3(b,C0[r+2],C0[r+3]);a=MX3(a,C1[r],C1[r+1]);b=MX3(b,C1[r+2],C1[r+3]);} \
      float rm=__builtin_fmaxf(a,b); { auto rr=__builtin_amdgcn_permlane32_swap(__float_as_uint(rm),__float_as_uint(rm),false,false); rm=__builtin_fmaxf(__uint_as_float(rr[0]),__uint_as_float(rr[1])); } \
      resc=false; \
      if(__builtin_expect(__any(rm>(float)THRL),0)){ const float dl=__builtin_fmaxf(rm,0.f); mhat+=dl; \
        _Pragma("unroll") for(int r=0;r<16;++r){C0[r]-=dl;C1[r]-=dl;} \
        const float f=__builtin_amdgcn_exp2f(-dl); l_reg*=f; if(hi==0)wsf[r32]=f; resc=true; } } \
    SBAR(); \
    GAPB(o[0]=__builtin_amdgcn_mfma_f32_32x32x16_bf16(PAF(0),VFR(0),o[0],0,0,0), C0,0); \
    GAPB(o[1]=__builtin_amdgcn_mfma_f32_32x32x16_bf16(PAF(0),VFR(4),o[1],0,0,0), C0,4); \
    KRD(GL,0); GAPB(o[0]=__builtin_amdgcn_mfma_f32_32x32x16_bf16(PAF(1),VFR(1),o[0],0,0,0), C0,8); \
    KRD(GL,1); GAPB(o[1]=__builtin_amdgcn_mfma_f32_32x32x16_bf16(PAF(1),VFR(5),o[1],0,0,0), C0,12); \
    KRD(GL,2); GAPB(o[0]=__builtin_amdgcn_mfma_f32_32x32x16_bf16(PAF(2),VFR(2),o[0],0,0,0), C1,0); \
    KRD(GL,3); GAPB(o[1]=__builtin_amdgcn_mfma_f32_32x32x16_bf16(PAF(2),VFR(6),o[1],0,0,0), C1,4); \
    GAPB(o[0]=__builtin_amdgcn_mfma_f32_32x32x16_bf16(PAF(3),VFR(3),o[0],0,0,0), C1,8); \
    GAPB(o[1]=__builtin_amdgcn_mfma_f32_32x32x16_bf16(PAF(3),VFR(7),o[1],0,0,0), C1,12); \
    }while(0)
  int t=1;
  for(;t+5<NT;t+=2){
    STEP(pB0,pB1,pA0,pA1,t,true,true,true);     WAIT_BAR(2); RESC(); ROT();
    STEP(pA0,pA1,pB0,pB1,t+1,true,true,true);   WAIT_BAR(2); RESC(); ROT();
  }
  #define ENDW(tt) do{ if((tt)+3<NT){WAIT_BAR(2);} else if((tt)+2<NT){WAIT_BAR(1);} else {WAIT_BAR(0);} }while(0)
  for(;t+1<NT;t+=2){
    STEP(pB0,pB1,pA0,pA1,t,(t+3<NT),(t+1<NT),(t+1<NT));       ENDW(t);   RESC(); ROT();
    STEP(pA0,pA1,pB0,pB1,t+1,(t+4<NT),(t+2<NT),(t+2<NT));     ENDW(t+1); RESC(); ROT();
  }
  STEP(pB0,pB1,pA0,pA1,NT-1,false,false,false); RESC();
  { float sacc=pB0[0]+pB0[1]; _Pragma("unroll") for(int r=2;r<16;++r)sacc+=pB0[r]; _Pragma("unroll") for(int r=0;r<16;++r)sacc+=pB1[r]; l_reg+=sacc;
    pw0=(u32x4){PKW(pB0,0),PKW(pB0,2),PKW(pB0,4),PKW(pB0,6)};pw1=(u32x4){PKW(pB0,8),PKW(pB0,10),PKW(pB0,12),PKW(pB0,14)};pw2=(u32x4){PKW(pB1,0),PKW(pB1,2),PKW(pB1,4),PKW(pB1,6)};pw3=(u32x4){PKW(pB1,8),PKW(pB1,10),PKW(pB1,12),PKW(pB1,14)};
    SBAR(); pv(o,vb0+sl_cur,PAF(0),PAF(1),PAF(2),PAF(3)); }
  #undef PKW
  #undef PAF
  #undef VFR
  #undef PIN
  #undef MX3
  #undef GAPA
  #undef GAPB
  #undef EX
  #undef VRD
  #undef KRD
  #undef STEP
  #undef ENDW
  {auto rr=__builtin_amdgcn_permlane32_swap(__float_as_uint(l_reg),__float_as_uint(l_reg),false,false);l_reg=__uint_as_float(rr[0])+__uint_as_float(rr[1]);}
  if(hi==0)wsf[32+r32]=l_reg;asm volatile("s_waitcnt lgkmcnt(0)":::"memory");
  float rli[16];
  #pragma unroll
  for(int r=0;r<16;++r)rli[r]=__builtin_amdgcn_rcpf(wsf[32+crow(r,hi)]);
  bf16*Ow=Ow0+(long)(wid*QBLK)*OP;
  { bf16*stg=(bf16*)(shm+LDS_OST)+wid*2048;
    #pragma unroll
    for(int r=0;r<16;++r){const int orow=crow(r,hi);
      #pragma unroll
      for(int d0=0;d0<2;++d0)stg[orow*64+d0*32+r32]=__float2bfloat16(o[d0][r]*rli[r]);}
    asm volatile("s_waitcnt lgkmcnt(0)":::"memory");
    #pragma unroll
    for(int i=0;i<4;++i){const int row=i*8+(lane>>3),ch=lane&7; const u32x4 v=*(const u32x4*)(stg+row*64+ch*8); ATTN_STORE16(Ow+(long)row*OP+ch*8,v);} }
  asm volatile("s_waitcnt lgkmcnt(0)\n\ts_barrier":::"memory");
  #undef DMA_K
  #undef TROW
  #undef DMA_V
  #undef CMASK
  #undef START
  #undef RESC
  #undef ROT
}
constexpr int ATTN_LDS_BYTES=LDS_BYTES;
#undef SBAR
#undef WAIT_BAR
}
__device__ __forceinline__ void attn_unit_simple(ldsp lds, const bf16_t* QKV, bf16_t* O, int qrow0, int h, int latbase, int nlat_tiles, int ctxbase, int NT, const int tid) {
    const int lane = tid & 63, wid = __builtin_amdgcn_readfirstlane(tid >> 6), l15 = lane & 15, lg = lane >> 4;
    const int kvh = h >> 2;
    const ldsp Kb = lds, Vb = lds + 18432, Pw = lds + 36864 + wid * 4608;
    bf16x8 qf[2][2];
#pragma unroll
    for (int qb = 0; qb < 2; ++qb)
#pragma unroll
        for (int ks = 0; ks < 2; ++ks) qf[qb][ks] = *(const bf16x8*)(QKV + (size_t)(qrow0 + 32 * wid + 16 * qb + l15) * 1536 + h * 64 + 32 * ks + 8 * lg);
    const int lrow = tid >> 3, lch = tid & 7;
    u32x4 kr, vr;
    { const int r = ((0 < nlat_tiles) ? latbase : ctxbase) + lrow; const bf16_t* p = QKV + (size_t)r * 1536 + 1024 + kvh * 64 + lch * 8; kr = *(const u32x4*)p; vr = *(const u32x4*)(p + 256); }
    *(LAS u32x4*)(Kb + lrow * 144 + lch * 16) = kr; *(LAS u32x4*)(Vb + lrow * 144 + lch * 16) = vr;
    __syncthreads();
    f32x4 o[4][2];
#pragma unroll
    for (int db = 0; db < 4; ++db) { o[db][0] = (f32x4){0.f, 0.f, 0.f, 0.f}; o[db][1] = o[db][0]; }
    float mrun[2] = {-INFINITY, -INFINITY}, lsum[2] = {0.f, 0.f};
    for (int t = 0; t < NT; ++t) {
        const int cur = t & 1;
        if (t + 1 < NT) { const int tn = t + 1; const int r = ((tn < nlat_tiles) ? latbase + 64 * tn : ctxbase + 64 * (tn - nlat_tiles)) + lrow;
            const bf16_t* p = QKV + (size_t)r * 1536 + 1024 + kvh * 64 + lch * 8; kr = *(const u32x4*)p; vr = *(const u32x4*)(p + 256); }
        f32x4 s[4][2];
#pragma unroll
        for (int kb = 0; kb < 4; ++kb) {
            const ldsp kp = Kb + cur * 9216 + (16 * kb + l15) * 144 + lg * 16;
            const bf16x8 k0 = *(const LAS bf16x8*)kp, k1 = *(const LAS bf16x8*)(kp + 64);
#pragma unroll
            for (int qb = 0; qb < 2; ++qb) { s[kb][qb] = mfma16(k0, qf[qb][0], (f32x4){0.f, 0.f, 0.f, 0.f}); s[kb][qb] = mfma16(k1, qf[qb][1], s[kb][qb]); }
        }
#pragma unroll
        for (int qb = 0; qb < 2; ++qb) {
            float mx = s[0][qb][0];
#pragma unroll
            for (int kb = 0; kb < 4; ++kb)
#pragma unroll
                for (int j = 0; j < 4; ++j) mx = fmaxf(mx, s[kb][qb][j]);
            mx = fmaxf(mx, __shfl_xor(mx, 16)); mx = fmaxf(mx, __shfl_xor(mx, 32));
            const float mn = fmaxf(mrun[qb], mx), al = __builtin_amdgcn_exp2f(mrun[qb] - mn); mrun[qb] = mn;
            float ps = 0.f;
#pragma unroll
            for (int kb = 0; kb < 4; ++kb) {
                float p[4];
#pragma unroll
                for (int j = 0; j < 4; ++j) { p[j] = __builtin_amdgcn_exp2f(s[kb][qb][j] - mn); ps += p[j]; }
                u32x2 w; w.x = cvt_pk_bf16(p[0], p[1]); w.y = cvt_pk_bf16(p[2], p[3]);
                *(LAS u32x2*)(Pw + (16 * qb + l15) * 144 + (16 * kb + 4 * lg) * 2) = w;
            }
            lsum[qb] = lsum[qb] * al + ps;
#pragma unroll
            for (int db = 0; db < 4; ++db) o[db][qb] *= al;
        }
#pragma unroll
        for (int ks = 0; ks < 2; ++ks) {
            bf16x8 pf[2];
#pragma unroll
            for (int qb = 0; qb < 2; ++qb) pf[qb] = *(const LAS bf16x8*)(Pw + (16 * qb + l15) * 144 + (32 * ks + 8 * lg) * 2);
#pragma unroll
            for (int db = 0; db < 4; ++db) {
                const ldsp vp = Vb + cur * 9216 + (32 * ks + 8 * lg + (l15 >> 2)) * 144 + (16 * db + 4 * (l15 & 3)) * 2;
                const s16x4 lo = lds_tr(vp), hi = lds_tr(vp + 4 * 144);
                const bf16x8 vf = (bf16x8){lo[0], lo[1], lo[2], lo[3], hi[0], hi[1], hi[2], hi[3]};
#pragma unroll
                for (int qb = 0; qb < 2; ++qb) o[db][qb] = mfma16(vf, pf[qb], o[db][qb]);
            }
        }
        if (t + 1 < NT) { *(LAS u32x4*)(Kb + (cur ^ 1) * 9216 + lrow * 144 + lch * 16) = kr; *(LAS u32x4*)(Vb + (cur ^ 1) * 9216 + lrow * 144 + lch * 16) = vr; }
        __syncthreads();
    }
#pragma unroll
    for (int qb = 0; qb < 2; ++qb) {
        float l = lsum[qb]; l += __shfl_xor(l, 16); l += __shfl_xor(l, 32);
        const float inv = 1.0f / l;
        bf16_t* op = O + (size_t)(qrow0 + 32 * wid + 16 * qb + l15) * D + h * 64 + 4 * lg;
#pragma unroll
        for (int db = 0; db < 4; ++db) { u32x2 w; w.x = cvt_pk_bf16(o[db][qb][0] * inv, o[db][qb][1] * inv); w.y = cvt_pk_bf16(o[db][qb][2] * inv, o[db][qb][3] * inv);
            *(u32x2*)(op + 16 * db) = w; }
    }
}
#ifndef ATT_SIMPLE
#define ATT_SIMPLE 0
#endif
__device__ __forceinline__ void attn_phase(ldsp lds, char* shm, const bf16_t* QKV, bf16_t* O, const int tid, const int bx) {
    const int xcd = bx & 7, slot = bx >> 3;
    typedef attn_body::bf16 abf;
    for (int i = 0; i < 4; ++i) {
        const int bk = 8 * i + xcd, b = bk >> 2, kvh = bk & 3, h = kvh * 4 + (slot >> 3), qb = slot & 7;
#if ATT_SIMPLE
        attn_unit_simple(lds, QKV, O, b * SEQ + qb * 256, h, b * SEQ, 32, ML + b * CL, 36, tid);
#else
        attn_body::attn_unit<8>((const abf*)(QKV + (size_t)(b * SEQ + qb * 256) * 1536 + h * 64), (const abf*)(QKV + 1024 + kvh * 64), b * SEQ, 32, ML + b * CL, 36,
                                (abf*)(O + (size_t)(b * SEQ + qb * 256) * D + h * 64), shm, tid);
#endif
    }
    if (slot < 16) { const int b = xcd, h = slot;
#if ATT_SIMPLE
        attn_unit_simple(lds, QKV, O, ML + b * CL, h, 0, 0, ML + b * CL, 4, tid);
#else
        attn_body::attn_unit<8>((const abf*)(QKV + (size_t)(ML + b * CL) * 1536 + h * 64), (const abf*)(QKV + 1024 + (h >> 2) * 64), 0, 0, ML + b * CL, 4,
                                (abf*)(O + (size_t)(ML + b * CL) * D + h * 64), shm, tid);
#endif
    }
}

__device__ __forceinline__ void ret_unit(ldsp lds, bf16_t* R, const bf16_t* RC, int b, int h, int qblk, float lgf2, float lgb2, const int tid_in) {
    int tl0_ = tid_in; asm volatile("" : "+v"(tl0_));
    const int tid_outer = tl0_;
    const int wid = __builtin_amdgcn_readfirstlane(tid_outer >> 6);
    const ldsp Ks = lds, Vs = lds + 67584, Ps = lds + 134144;
    const int q0 = qblk * 64, rowq0 = b * SEQ + q0;
    const int qb = wid & 3, kbp = wid >> 2;
    bf16x8 qf[8];
    { const int l15 = tid_outer & 15, lg = (tid_outer & 63) >> 4;
#pragma unroll
      for (int ks = 0; ks < 8; ++ks) qf[ks] = *(const bf16x8*)(R + (size_t)(rowq0 + 16 * qb + l15) * 6144 + h * 256 + 32 * ks + 8 * lg); }
    u32x4 vr[8];
#define RET_BAR() do { asm volatile("s_waitcnt lgkmcnt(0)" ::: "memory"); __builtin_amdgcn_s_barrier(); asm volatile("" ::: "memory"); } while (0)
#define RET_KV(t) const char* kb_; unsigned kp_; \
        if ((t) < 32) { kb_ = (const char*)(R + (size_t)(b * SEQ + 64 * (t)) * 6144 + 1024 + h * 256); kp_ = 6144u * 2u; } \
        else { kb_ = (const char*)(RC + (size_t)(b * CL + 64 * ((t) - 32)) * 3072 + h * 256); kp_ = 3072u * 2u; }
#define RET_DMAK(t, buf) do { RET_KV(t) const int hf_ = lane >> 5; \
        _Pragma("unroll") for (int i_ = 0; i_ < 4; ++i_) { const int pp_ = 4 * wid + i_; const int row_ = 16 * (pp_ >> 3) + (pp_ & 7) + 8 * hf_; \
            attn_body::glds16(kb_ + (size_t)row_ * kp_ + (unsigned)(((lane & 31) ^ hf_) * 16), (unsigned)__builtin_amdgcn_readfirstlane((int)(unsigned)(size_t)(Ks + (buf) * 33792 + pp_ * 1056))); } } while (0)
#define RET_LOADV(t) do { RET_KV(t) const char* vb_ = kb_ + (1024 + h * 256) * 2; const unsigned lo_ = (unsigned)(tid >> 6) * kp_ + (unsigned)(tid & 63) * 16u; \
        _Pragma("unroll") for (int i_ = 0; i_ < 8; ++i_) vr[i_] = *(const u32x4*)(vb_ + (size_t)(8u * i_) * kp_ + lo_); } while (0)
#define RET_STOREV() do { _Pragma("unroll") for (int i_ = 0; i_ < 8; ++i_) *(LAS u32x4*)(Vs + ((tid >> 6) + 8 * i_) * 1040 + (tid & 63) * 16) = vr[i_]; } while (0)
#define RET_S(t) do { const ldsp pbuf_ = Ps + ((t) & 1) * 9216; \
        const ldsp krd_ = Ks + ((t) & 1) * 33792 + (l15 & 7) * 1056 + (l15 >> 3) * 512; const int hx_ = l15 >> 3; \
        f32x4 s_[2]; s_[0] = (f32x4){0.f, 0.f, 0.f, 0.f}; s_[1] = s_[0]; \
        _Pragma("unroll") for (int ks = 0; ks < 8; ++ks) { _Pragma("unroll") for (int kk = 0; kk < 2; ++kk) { \
            const bf16x8 kf_ = *(const LAS bf16x8*)(krd_ + (2 * kbp + kk) * 8 * 1056 + (((4 * ks + lg) ^ hx_) * 16)); s_[kk] = mfma16(kf_, qf[ks], s_[kk]); } } \
        const int p_ = q0 + 16 * qb + l15; \
        _Pragma("unroll") for (int kk = 0; kk < 2; ++kk) { float pv_[4]; \
            _Pragma("unroll") for (int j = 0; j < 4; ++j) { const int key_ = 16 * (2 * kbp + kk) + 4 * lg + j; float w_; \
                if ((t) < 32) { const int d_ = p_ - (64 * (t) + key_); w_ = (d_ >= 0) ? __builtin_amdgcn_exp2f(lgf2 * (float)d_) : __builtin_amdgcn_exp2f(lgb2 * (float)(-d_)); } \
                else { const int jj_ = 64 * ((t) - 32) + key_; w_ = __builtin_amdgcn_exp2f(lgf2 * (float)(p_ + CL - jj_)) + __builtin_amdgcn_exp2f(lgb2 * (float)(SEQ - p_ + jj_)); } \
                pv_[j] = s_[kk][j] * w_; } \
            u32x2 w2_; w2_.x = cvt_pk_bf16(pv_[0], pv_[1]); w2_.y = cvt_pk_bf16(pv_[2], pv_[3]); \
            *(LAS u32x2*)(pbuf_ + (16 * qb + l15) * 144 + (16 * (2 * kbp + kk) + 4 * lg) * 2) = w2_; } } while (0)
#define RET_PV(t) do { const ldsp pbuf_ = Ps + ((t) & 1) * 9216; \
        _Pragma("unroll") for (int ks = 0; ks < 2; ++ks) { bf16x8 pf_[4]; \
            _Pragma("unroll") for (int q4 = 0; q4 < 4; ++q4) pf_[q4] = *(const LAS bf16x8*)(pbuf_ + (16 * q4 + l15) * 144 + (32 * ks + 8 * lg) * 2); \
            _Pragma("unroll") for (int db = 0; db < 4; ++db) { \
                const ldsp vp_ = Vs + (32 * ks + 8 * lg + (l15 >> 2)) * 1040 + (64 * wid + 16 * db + 4 * (l15 & 3)) * 2; \
                const s16x4 lo_ = lds_tr(vp_), hi_ = lds_tr(vp_ + 4 * 1040); \
                const bf16x8 vf_ = (bf16x8){lo_[0], lo_[1], lo_[2], lo_[3], hi_[0], hi_[1], hi_[2], hi_[3]}; \
                _Pragma("unroll") for (int q4 = 0; q4 < 4; ++q4) o[db][q4] = mfma16(vf_, pf_[q4], o[db][q4]); } } } while (0)
    f32x4 o[4][4];
#pragma unroll
    for (int db = 0; db < 4; ++db)
#pragma unroll
        for (int q4 = 0; q4 < 4; ++q4) o[db][q4] = (f32x4){0.f, 0.f, 0.f, 0.f};
    { const int tid = tid_outer, lane = tid & 63, l15 = lane & 15, lg = lane >> 4;
      RET_BAR();
      RET_DMAK(0, 0); RET_DMAK(1, 1); RET_LOADV(0);
      asm volatile("s_waitcnt vmcnt(0)" ::: "memory");
      RET_STOREV();
      RET_BAR();
      RET_S(0);
      RET_LOADV(1);
      RET_BAR();
      RET_DMAK(2, 0); }
    for (int t = 0; t < 36; ++t) {
        int tl_ = tid_outer; asm volatile("" : "+v"(tl_));
        const int tid = tl_, lane = tid & 63, l15 = lane & 15, lg = lane >> 4;
        if (wid < 4) { RET_PV(t); if (t + 1 < 36) RET_S(t + 1); }
        else { if (t + 1 < 36) RET_S(t + 1); RET_PV(t); }
        RET_BAR();
        asm volatile("s_waitcnt vmcnt(0)" ::: "memory");
        if (t + 1 < 36) RET_STOREV();
        if (t + 2 < 36) RET_LOADV(t + 2);
        if (t + 3 < 36) RET_DMAK(t + 3, (t + 1) & 1);
        RET_BAR();
    }
#undef RET_KV
#undef RET_DMAK
#undef RET_LOADV
#undef RET_STOREV
#undef RET_S
#undef RET_PV
    const int lane = tid_outer & 63, l15 = lane & 15, lg = lane >> 4;
    LAS float* red = (LAS float*)Ps;
#pragma unroll
    for (int q4 = 0; q4 < 4; ++q4) {
        float ss = 0.f;
#pragma unroll
        for (int db = 0; db < 4; ++db)
#pragma unroll
            for (int j = 0; j < 4; ++j) ss += o[db][q4][j] * o[db][q4][j];
        ss += __shfl_xor(ss, 16); ss += __shfl_xor(ss, 32);
        if (lg == 0) red[wid * 64 + 16 * q4 + l15] = ss;
    }
    RET_BAR();
#pragma unroll
    for (int q4 = 0; q4 < 4; ++q4) {
        float tot = 0.f;
#pragma unroll
        for (int w = 0; w < 8; ++w) tot += red[w * 64 + 16 * q4 + l15];
        const float rstd = 1.0f / sqrtf(tot * (1.f / 512.f) + EPS);
        bf16_t* gp = R + (size_t)(rowq0 + 16 * q4 + l15) * 6144 + 4096 + h * 512 + 64 * wid + 4 * lg;
#pragma unroll
        for (int db = 0; db < 4; ++db) { const u32x2 g2 = *(const u32x2*)(gp + 16 * db);
            u32x2 w; w.x = cvt_pk_bf16(o[db][q4][0] * rstd * silu_f(bflo(g2.x)), o[db][q4][1] * rstd * silu_f(bfhi(g2.x)));
            w.y = cvt_pk_bf16(o[db][q4][2] * rstd * silu_f(bflo(g2.y)), o[db][q4][3] * rstd * silu_f(bfhi(g2.y)));
            *(u32x2*)(gp + 16 * db) = w; }
    }
    RET_BAR();
#undef RET_BAR
}
__device__ __forceinline__ void ret_phase(ldsp lds, bf16_t* R, const bf16_t* RC, const float* decay, const int tid, const int bx) {
    const int xcd = bx & 7, slot = bx >> 3;
    for (int i = 0; i < 4; ++i) {
        const int bh = 8 * i + xcd, b = bh >> 2, h = bh & 3;
        const float lgf2 = decay[h], lgb2 = decay[4 + h];
        ret_unit(lds, R, RC, b, h, slot, lgf2, lgb2, tid);
    }
}

#define XB_TMO      128
#define XB_XCNT(j)  (256  + 64 * (j))
#define XB_XSUB(j)  (1280 + 64 * (j))
#define XB_XGEN(j)  (2304 + 64 * (j))
#define XB_TOP      3328
#define XB_TOPGEN   3392
#define XB_SPIN_CAP (1u << 22)
__device__ __forceinline__ unsigned xb_ld(unsigned* p)              { return __hip_atomic_load(p, __ATOMIC_RELAXED, __HIP_MEMORY_SCOPE_AGENT); }
__device__ __forceinline__ unsigned xb_add(unsigned* p, unsigned v) { return __hip_atomic_fetch_add(p, v, __ATOMIC_RELAXED, __HIP_MEMORY_SCOPE_AGENT); }
__device__ __forceinline__ unsigned xb_xcc_id() { return (unsigned)__builtin_amdgcn_s_getreg((3 << 11) | 20) & 0xFu; }
#define XB_SPIN(cond, bar) do { unsigned _sp = 0; while (cond) { __builtin_amdgcn_s_sleep(1); \
    if ((++_sp & 255u) == 0u) { if (xb_ld(&(bar)[XB_TMO])) break; if (_sp > XB_SPIN_CAP) { atomicAdd(&(bar)[XB_TMO], 1u); break; } } } } while (0)
__device__ __forceinline__ void xcd_barrier_complete(unsigned* bar, unsigned x, unsigned& nloc, unsigned& nx) {
    const unsigned G = gridDim.x * gridDim.y * gridDim.z;
    unsigned sum, cnt, mine, sp = 0u;
    for (;;) {
        sum = 0u; cnt = 0u; mine = 0u;
#pragma unroll
        for (unsigned j = 0; j < 16; ++j) { const unsigned c = xb_ld(&bar[XB_XCNT(j)]); sum += c; cnt += (c > 0u) ? 1u : 0u; mine = (j == x) ? c : mine; }
        if (sum == G) break;
        __builtin_amdgcn_s_sleep(1);
        if ((++sp & 255u) == 0u) { if (xb_ld(&bar[XB_TMO])) break; if (sp > XB_SPIN_CAP) { atomicAdd(&bar[XB_TMO], 1u); break; } }
    }
    nloc = mine > 0u ? mine : 1u; nx = cnt > 0u ? cnt : 1u;
}
__device__ __forceinline__ void xcd_barrier(unsigned* bar, volatile LAS unsigned* st, const int tid) {
    asm volatile("s_waitcnt vmcnt(0)" ::: "memory");
    __syncthreads();
    if (tid == 0) {
        const unsigned x = xb_xcc_id();
        __builtin_amdgcn_s_waitcnt(0);
        unsigned nloc = st[0], nx = st[1];
        if (nloc == 0u) { xcd_barrier_complete(bar, x, nloc, nx); st[0] = nloc; st[1] = nx; }
        const unsigned old = xb_add(&bar[XB_XSUB(x)], 1u);
        const unsigned gen = old / nloc;
        if (old + 1u == (gen + 1u) * nloc) {
            __builtin_amdgcn_fence(__ATOMIC_RELEASE, "agent");
            asm volatile("s_waitcnt vmcnt(0)" ::: "memory");
            const unsigned og = xb_add(&bar[XB_TOP], 1u);
            const unsigned tg = og / nx;
            if (og + 1u == (tg + 1u) * nx) xb_add(&bar[XB_TOPGEN], 1u);
            else XB_SPIN(xb_ld(&bar[XB_TOPGEN]) == tg, bar);
            __builtin_amdgcn_fence(__ATOMIC_ACQUIRE, "agent");
            xb_add(&bar[XB_XGEN(x)], 1u);
            asm volatile("s_waitcnt vmcnt(0)" ::: "memory");
        } else {
            XB_SPIN(xb_ld(&bar[XB_XGEN(x)]) == gen, bar);
            __builtin_amdgcn_fence(__ATOMIC_ACQUIRE, "agent");
            asm volatile("s_waitcnt vmcnt(0)" ::: "memory");
        }
    }
    __syncthreads();
}

constexpr int N_PHASES = 42;
__global__ void __launch_bounds__(512, 2) fwd_megakernel(Args a_in) {
    extern __shared__ __attribute__((aligned(16))) unsigned char lds_raw[];
    const ldsp lds = (ldsp)lds_raw;
    cg::grid_group grid = cg::this_grid();
    { volatile LAS unsigned* st0 = (volatile LAS unsigned*)(lds + MISC_OFF);
      if (threadIdx.x < 16) st0[threadIdx.x] = 0u;
      __syncthreads();
      if (threadIdx.x == 0 && a_in.coop) (void)xb_add(&((unsigned*)(a_in.ws + WS_CTL))[XB_XCNT(xb_xcc_id())], 1u); }
    bool need_sync = false; int zz = 0;
    const int ph_lo = a_in.ph_lo, ph_hi = a_in.ph_hi, coop = a_in.coop;
    for (int ph = ph_lo; ph < ph_hi; ++ph) {
        const __attribute__((address_space(4))) Args* apz = (const __attribute__((address_space(4))) Args*)__builtin_amdgcn_kernarg_segment_ptr();
        asm volatile("" : "+s"(apz));
        const __attribute__((address_space(4))) Args& a = *apz;
        int tid = threadIdx.x; asm volatile("" : "+v"(tid));
        const int wave = __builtin_amdgcn_readfirstlane(tid >> 6);
#define LANE_ ({ int t__ = tid; asm volatile("" : "+v"(t__)); t__ & 63; })
        int bid = blockIdx.x; asm volatile("" : "+s"(bid));
        const int G = gridDim.x, gw = bid * 8 + wave, NGW = G * 8, gtid = bid * 512 + tid, NTH = G * 512;
        unsigned char* ws = a.ws;
        float* mods = (float*)(ws + WS_MODS);
        float* XC = (float*)(ws + WS_XC);
        bf16_t* H = (bf16_t*)(ws + WS_H);
        bf16_t* U = (bf16_t*)(ws + WS_U);
        bf16_t* RC = (bf16_t*)(ws + WS_RC);
        bf16_t* SIDE = (bf16_t*)(ws + WS_SIDE);
        int kind = -1, layer = 0, slot = 0;
        if (ph == 0) kind = 0; else if (ph == 41) kind = 8;
        else { layer = (ph - 1) / 10; slot = (ph - 1) % 10;
            kind = (slot == 0 || slot == 5) ? 1 : (slot == 1 || slot == 6) ? 2 : slot == 2 ? 3 : slot == 3 ? 4 : (slot == 4 || slot == 9) ? 5 : slot == 7 ? 6 : 7; }
        const int mixer = layer % 3;
        if (kind == 4 && mixer == 0) continue;
        if (kind == 6) continue;
        if (kind == 3 && mixer != 0) continue;
        const bool fusedn = (G == 256);
        const int rows_full = (layer < 2) ? MT : ML;
        const int nrows = (kind == 1) ? ((slot == 0 && layer == 2) ? MT : rows_full) : 0;
        const int nrow0 = (kind == 1 && fusedn && ph > 1) ? ML : 0;
        if (kind == 1 && nrows <= nrow0) continue;
        if (kind == 8 && fusedn) continue;
        const int zr = (kind == 5) ? PROBE_GR : (kind == 7) ? PROBE_GB : 1;
        const bool dummy = zz + 1 < zr;
        if (need_sync && coop) { for (int z = 0; z <= PROBE_SYNC; ++z) { if (a.pad == 0x5eed) grid.sync(); else xcd_barrier((unsigned*)(ws + WS_CTL), (volatile LAS unsigned*)(lds + MISC_OFF), tid); } }
        need_sync = true;
        const float* modl = mods + (size_t)layer * 9 * NMOD;
        const float* xs_lat = (layer == 0 && slot <= 4) ? a.x : a.out;
        const float* xs_ctx = XC;
        if (kind == 0) {
#ifndef NO_PRO
 for (int z = 0; z < PROBE_PRO; ++z) prologue(a, lds, gw, NGW, wave, LANE_, tid, bid, G);
#endif
 }
        else if (kind == 1) {
            const bool mix = slot == 0; const int rows = nrows;
            const bool haspart = (ph > 1) && (ph <= 21);
            norm_phase(xs_lat, xs_ctx, haspart ? (const float*)(ws + WS_PARTA) : nullptr, (const float*)(ws + WS_PARTB), XC, nrow0, rows, (mix ? a.norm_mix_g : a.norm_ffn_g) + layer * D, modl, mix ? 0 : 3072, mix ? 1024 : 4096, H, gw, NGW, LANE_);
        } else if (kind == 2) {
            const bool retl = (slot == 1 && mixer == 2);
            if (retl) {
                pg8::Gemm g{H, (const bf16_t*)(ws + WS_RIN), ML, 2048, D, D, D}; pg8::EpiRope ER{U, 6144, 4};
                pg8::StaticOrder S; S.init(g.M, g.N, G, bid);
                pg8::gemm_phase<pg8::EpiRope>(lds, g, S, ER, tid);
            }
            if (slot == 1 && mixer == 1) {
                pg8::Gemm g{H, (const bf16_t*)(ws + WS_AQKV), MT, 1536, D, D, D}; pg8::EpiQKV EQ{U, a.attn_qg, a.attn_kg};
                pg8::StaticOrder S; S.init(g.M, g.N, G, bid);
                pg8::gemm_phase<pg8::EpiQKV>(lds, g, S, EQ, tid);
            }
            if (slot == 6) {
                pg8::Gemm g{H, (const bf16_t*)(ws + WS_UP) + (size_t)layer * DFF2 * D, rows_full, DFF2, D, D, D};
                pg8::EpiGate EG{U, SIDE, a.ffn_conv_k + (size_t)layer * 3 * DFF2, a.ffn_conv_b + (size_t)layer * DFF2};
                pg8::StaticOrder S; S.init(g.M, g.N, G, bid);
                pg8::gemm_phase<pg8::EpiGate>(lds, g, S, EG, tid);
            }
            const int nrep = retl ? 2 : ((slot == 1 && mixer == 1) || slot == 6) ? 0 : 1;
            for (int rep0 = 0; rep0 < nrep * PROBE_GS; ++rep0) { const int rep = rep0 % nrep;
                pg8::Gemm g; pg8::EpiStore E;
                if (mixer == 0) { g = pg8::Gemm{H, (const bf16_t*)(ws + WS_CIN) + (size_t)(layer / 3) * 3072 * D, rows_full, 3072, D, D, D}; E = pg8::EpiStore{U, 3072, nullptr, 0, 1.0f}; }
                else if (rep == 0) { g = pg8::Gemm{H, (const bf16_t*)(ws + WS_RIN) + (size_t)2048 * D, ML, 4096, D, D, D}; E = pg8::EpiStore{U + 2048, 6144, nullptr, 0, 1.0f}; }
                else { g = pg8::Gemm{H + (size_t)ML * D, (const bf16_t*)(ws + WS_RIN) + (size_t)1024 * D, MC, 3072, D, D, D}; E = pg8::EpiStore{RC, 3072, nullptr, 4, 0.0625f}; }
                pg8::StaticOrder S; S.init(g.M, g.N, G, bid);
#ifndef NO_GS
                pg8::gemm_phase<pg8::EpiStore>(lds, g, S, E, tid);
#endif
            }
            { const int cset = (ph == 2) ? 1 : (ph == 7) ? 2 : (ph == 17) ? 3 : 0, c0 = (ph == 2) ? 96 : 48;
              if (cset != 0 && G == 256 && bid >= c0) convert_set(a, lds, cset, (bid - c0) * 8 + wave, (256 - c0) * 8, wave, LANE_); }
        } else if (kind == 3) {
#ifndef NO_PREP
            if (mixer == 0) for (int z = 0; z < PROBE_EW; ++z) convgate_phase(U, H, rows_full, a.conv_k + (size_t)(layer / 3) * 3 * D, gw, NGW, LANE_);
            else if (mixer == 1) attnprep_phase(U, a.attn_qg, a.attn_kg, gw, NGW, LANE_);
            else retprep_phase(U, RC, gw, NGW, LANE_);
#endif
        } else if (kind == 4) {
#ifndef NO_ATT
            if (mixer == 1) for (int z = 0; z < PROBE_ATT; ++z) attn_phase(lds, (char*)lds_raw, U, H, tid, bid);
#endif
#ifndef NO_RET
            if (mixer == 2) ret_phase(lds, U, RC, mods + 4 * 9 * NMOD, tid, bid);
#endif
        } else if (kind == 5) {
            const int nrep = (layer < 2) ? 3 : 1;
            for (int rep = 0; rep < nrep; ++rep) {
                pg8::Gemm g; int goff = 2048;
                if (slot == 9) { g = pg8::Gemm{U, (const bf16_t*)(ws + WS_DN) + (size_t)layer * D * DFF, ML, D, DFF, DFF, DFF}; goff = 5120; }
                else if (mixer == 0) { g = pg8::Gemm{H, (const bf16_t*)(ws + WS_COUT) + (size_t)(layer / 3) * D * D, ML, D, D, D, D}; }
                else if (mixer == 1) { g = pg8::Gemm{H, (const bf16_t*)(ws + WS_AOUT), ML, D, D, D, D}; }
                else { g = pg8::Gemm{U + 4096, (const bf16_t*)(ws + WS_ROUT), ML, D, 2048, 6144, 2048}; }
                int split = 1, cid = bid, kq0 = 0; unsigned kpart = 0u, koff0 = 0u;
                float* part = nullptr;
                if (rep > 0) {
                    g.A += (size_t)ML * g.lda; g.M = MC; split = 2; part = (float*)(ws + (rep == 1 ? WS_PARTA : WS_PARTB));
                    if (slot == 9) { if (rep == 1) { g.K = 768; kpart = 1536u; } else { g.K = 640; kpart = 1280u; koff0 = 3072u; cid = (bid + 192) & 255; } }
                    else { g.K = 256; kpart = 512u; if (rep == 2) { koff0 = 1024u; cid = (bid + 192) & 255; } }
                }
                pg8::StaticOrder S; S.init(g.M, g.N, G, cid, split, kpart, koff0, kq0);
                if (rep == 0 && fusedn) {
                    const bool fin = (slot == 9 && layer == 3); const int nl = (slot == 9) ? layer + 1 : layer;
                    const float* gain = fin ? a.final_g : ((slot == 9) ? a.norm_mix_g : a.norm_ffn_g) + nl * D;
                    const int inst = layer * 2 + (slot == 9 ? 1 : 0);
                    pg8::EpiResidNorm EN{xs_lat, a.out, modl + goff, gain, mods + (size_t)(fin ? 0 : nl) * 9 * NMOD, (slot == 9) ? 0 : 3072, (slot == 9) ? 1024 : 4096,
                                         H, (unsigned*)(ws + WS_XBUF), (unsigned*)(ws + WS_CTL + 16384 + inst * 16384), fin ? 1 : 0};
                    pg8::gemm_phase<pg8::EpiResidNorm>(lds, g, S, EN, tid);
                } else {
                    pg8::EpiResid E{xs_lat, XC, a.out, XC, dummy ? (const float*)(ws + WS_CTL + CTL_ZEROS) : modl + goff, rep ? ML : 0, part};
                    pg8::gemm_phase<pg8::EpiResid>(lds, g, S, E, tid);
                }
            }
        } else if (kind == 6) { for (int z = 0; z < PROBE_EW; ++z) ffngate_a(U, SIDE, rows_full, gtid, NTH); }
        else if (kind == 7) {
#ifndef NO_GB
 ffngate_fix(U, SIDE, rows_full, a.ffn_conv_k + (size_t)layer * 3 * DFF2, a.ffn_conv_b + (size_t)layer * DFF2, gw, NGW, LANE_);
#endif
 }
        else if (kind == 8) { final_phase(a.out, a.final_g, gw, NGW, LANE_); }
        if (dummy) { ++zz; --ph; } else zz = 0;
    }
}

extern "C" void kernel_launch(void* const* d_in, const int* in_sizes, int n_in, void* d_out, int out_size, void* d_ws, size_t ws_size, hipStream_t stream) {
    static int grid = 0;
    if (grid == 0) {
        if (n_in != 23 || out_size != ML * D || ws_size < WS_END) { fprintf(stderr, "kernel_launch: unexpected shapes (n_in %d out %d ws %zu)\n", n_in, out_size, ws_size); grid = -1; return; }
        int dev = 0, cus = 0, per_cu = 0;
        hipGetDevice(&dev);
        hipDeviceGetAttribute(&cus, hipDeviceAttributeMultiprocessorCount, dev);
        hipFuncSetAttribute((const void*)fwd_megakernel, hipFuncAttributeMaxDynamicSharedMemorySize, LDS_BYTES);
        hipOccupancyMaxActiveBlocksPerMultiprocessor(&per_cu, (const void*)fwd_megakernel, 512, LDS_BYTES);
        (void)hipGetLastError();
        if (per_cu < 1) per_cu = 1;
        grid = cus;
        if (grid != 256) fprintf(stderr, "kernel_launch: %d CUs (expected 256)\n", grid);
    }
    if (grid < 0) return;
    if (hipMemsetAsync((char*)d_ws + WS_CTL, 0, CTL_BYTES, stream) != hipSuccess) { fprintf(stderr, "kernel_launch: memset failed\n"); return; }
    Args a{};
    const float** ap = (const float**)&a;
    for (int i = 0; i < 23; ++i) ap[i] = (const float*)d_in[i];
    a.out = (float*)d_out; a.ws = (unsigned char*)d_ws;
#if MK_PER_PHASE
    for (int ph = 0; ph < N_PHASES; ++ph) { a.ph_lo = ph; a.ph_hi = ph + 1; a.coop = 0; hipLaunchKernelGGL(fwd_megakernel, dim3(grid), dim3(512), LDS_BYTES, stream, a); }
#else
    a.ph_lo = 0; a.ph_hi = N_PHASES; a.coop = 1;
    void* args[] = {&a};
    hipError_t e = hipLaunchCooperativeKernel((const void*)fwd_megakernel, dim3(grid), dim3(512), args, LDS_BYTES, stream);
    if (e != hipSuccess) fprintf(stderr, "cooperative launch failed: %s (grid %d)\n", hipGetErrorString(e), grid);
#endif
}
```

```cpp
#include <hip/hip_runtime.h>
#include <hip/hip_cooperative_groups.h>
#include <hip/hip_bf16.h>
#include <cmath>
#include <cstdio>
#include <cstdint>
namespace cg = cooperative_groups;

#define LAS __attribute__((address_space(3)))
typedef unsigned short bf16_t;
typedef short bf16x8 __attribute__((ext_vector_type(8)));
typedef short s16x4 __attribute__((ext_vector_type(4)));
typedef float f32x4 __attribute__((ext_vector_type(4)));
typedef float f32x2 __attribute__((ext_vector_type(2)));
typedef unsigned u32x4 __attribute__((ext_vector_type(4)));
typedef unsigned u32x2 __attribute__((ext_vector_type(2)));
typedef LAS unsigned char* ldsp;

#define PROBE_SYNC 0
#define PROBE_ATT 1
#define PROBE_RET 1
#define PROBE_GS 1
#define PROBE_EW 1
#define PROBE_GR 1
#define PROBE_GB 1
#define PROBE_PRO 1
#ifndef MK_PER_PHASE
#define MK_PER_PHASE 0
#endif

constexpr int D = 1024, NB = 8, SEQ = 2048, CL = 256, ML = NB * SEQ, MC = NB * CL, MT = ML + MC;
constexpr int DFF = 2816, DFF2 = 5632, NMOD = 6144;
constexpr float EPS = 1e-6f;
constexpr float C2 = 0.125f * 1.4426950408889634f;
constexpr float LOG2_THETA = 13.287712379549449f;
constexpr float INV_2PI = 0.15915494309189535f;

constexpr size_t MiB = 1u << 20;
constexpr size_t WS_MODS = 0;
constexpr size_t WS_CIN = 1 * MiB, WS_COUT = 13 * MiB, WS_AQKV = 17 * MiB, WS_AOUT = 20 * MiB, WS_RIN = 22 * MiB, WS_ROUT = 34 * MiB,
                 WS_UP = 38 * MiB, WS_DN = 82 * MiB;
constexpr size_t WS_XC = 104 * MiB;
constexpr size_t WS_H = 112 * MiB;
constexpr size_t WS_U = 148 * MiB;
constexpr size_t WS_RC = 340 * MiB;
constexpr size_t WS_SIDE = 352 * MiB;
constexpr size_t WS_CTL = 366 * MiB, CTL_BYTES = 262144, CTL_ZEROS = 16384;
constexpr size_t WS_PARTA = 346 * MiB, WS_PARTB = 367 * MiB;
constexpr size_t WS_XBUF = 365 * MiB;
constexpr size_t WS_END = 383 * MiB;
constexpr int LDS_BYTES = 163840, MISC_OFF = LDS_BYTES - 64;

__device__ __forceinline__ unsigned cvt_pk_bf16(float lo, float hi) { unsigned r; asm volatile("v_cvt_pk_bf16_f32 %0, %1, %2" : "=v"(r) : "v"(lo), "v"(hi)); return r; }
__device__ __forceinline__ float bflo(unsigned w) { return __uint_as_float(w << 16); }
__device__ __forceinline__ float bfhi(unsigned w) { return __uint_as_float(w & 0xffff0000u); }
__device__ __forceinline__ float wave_sum(float v) {
#pragma unroll
    for (int o = 1; o < 64; o <<= 1) v += __shfl_xor(v, o);
    return v;
}
__device__ __forceinline__ float silu_f(float x) { return x * __builtin_amdgcn_rcpf(1.0f + __builtin_amdgcn_exp2f(x * -1.4426950408889634f)); }
__device__ __forceinline__ f32x4 mfma16(bf16x8 a, bf16x8 b, f32x4 c) { return __builtin_amdgcn_mfma_f32_16x16x32_bf16(a, b, c, 0, 0, 0); }
typedef short v4i16_t __attribute__((ext_vector_type(4)));
__device__ __forceinline__ s16x4 lds_tr(ldsp p) { return __builtin_bit_cast(s16x4, __builtin_amdgcn_ds_read_tr16_b64_v4i16((LAS v4i16_t*)p)); }

namespace pg8 {
constexpr int BM = 256, BK = 64, HALF = 128, HTB = HALF * BK * 2, STAGE_BYTES = 8 * HTB, NXCD = 8, WGM = 8;
__device__ __forceinline__ int lds_byte(int r, int c) { const int st = (r >> 4) * 2 + (c >> 5), rr = r & 15, cc = c & 31, ob = rr * 64 + cc * 2; return st * 1024 + (ob ^ (((ob >> 9) & 1) << 5)); }
__device__ __forceinline__ void stage_rc(int b, int& R, int& C) { const int st = b / 1024, sb = b % 1024, swz = sb ^ (((sb >> 9) & 1) << 5); R = (st >> 1) * 16 + swz / 64; C = (st & 1) * 32 + (swz % 64) / 2; }
__device__ __forceinline__ int perm32(int rho) { const int n = rho >> 4, i = rho & 15; return 8 * (i >> 2) + 4 * n + (i & 3); }
struct Unit { int pm, pn; unsigned koff; int kq; };
struct Gemm { const bf16_t* A; const bf16_t* Bt; int M, N, K, lda, ldb; };
struct StaticOrder {
    int nM, nN, nwg, G, c, split, kq0; unsigned kpart, koff0;
    __device__ void init(int M, int N, int G_, int c_, int split_ = 1, unsigned kpart_ = 0u, unsigned koff0_ = 0u, int kq0_ = 0) { nM = M / BM; nN = N / BM; nwg = nM * nN; G = G_; c = c_; split = split_; kpart = kpart_; koff0 = koff0_; kq0 = kq0_; }
    __device__ __forceinline__ bool next(int i, Unit& u) const {
        const long L = (long)i * G + c;
        if (L >= (long)nwg * split) return false;
        int pm, pn, kq = 0; unsigned koff = 0u;
        if (split > 1) { kq = (int)(L % split); const int t = (int)(L / split); pm = t % nM; pn = t / nM; koff = koff0 + (unsigned)kq * kpart; }
        else {
            int wgid = (int)L; { const int q = nwg / NXCD, r = nwg % NXCD, xcd = wgid % NXCD, off = wgid / NXCD; wgid = (xcd < r ? xcd * (q + 1) : r * (q + 1) + (xcd - r) * q) + off; }
            const int nig = WGM * nN, gid = wgid / nig, fm = gid * WGM, gsz = (nM - fm) < WGM ? (nM - fm) : WGM;
            pm = fm + ((wgid % nig) % gsz); pn = (wgid % nig) / gsz; }
        u.pm = pm; u.pn = pn; u.koff = koff; u.kq = kq0 + kq; return true;
    }
};
struct EpiStore {
    static constexpr bool PERM = true, AFTER_DRAIN = false; static constexpr int BMAP = 0;
    bf16_t* O; int ldc; bf16_t* side; int scale_tiles; float scale;
    __device__ __forceinline__ void operator()(const f32x4 (&acc)[2][2][4][2], const Unit& u, int wr, int wc, int fr, int fq) const {
        char* base = (char*)(O + (size_t)(u.pm * BM) * ldc + u.pn * BM);
        char* sbase = (char*)(side + (size_t)(u.pm * 16) * ldc + u.pn * BM);
        const unsigned ldb = (unsigned)ldc * 2u; const float sc_ = (u.pn < scale_tiles) ? scale : 1.0f;
        unsigned off0 = (unsigned)(wr * 64 + fr) * ldb + (unsigned)(wc * 32 + 8 * fq) * 2u; asm volatile("" : "+v"(off0));
#pragma unroll
        for (int ai = 0; ai < 2; ++ai)
#pragma unroll
            for (int m = 0; m < 4; ++m) { const unsigned off = off0 + (unsigned)(ai * HALF + m * 16) * ldb;
#pragma unroll
                for (int bj = 0; bj < 2; ++bj) { const f32x4 v0 = acc[ai][bj][m][0] * sc_, v1 = acc[ai][bj][m][1] * sc_;
                    u32x4 w; w.x = cvt_pk_bf16(v0[0], v0[1]); w.y = cvt_pk_bf16(v0[2], v0[3]); w.z = cvt_pk_bf16(v1[0], v1[1]); w.w = cvt_pk_bf16(v1[2], v1[3]);
                    *(u32x4*)(base + off + bj * HALF * 2) = w;
                    if (side != nullptr && ((fr == 0 && (m & 1) == 0) || (fr == 15 && (m & 1) == 1))) {
                        const int slot = (ai * 4 + wr * 2 + (m >> 1)) * 2 + (m & 1);
                        *(u32x4*)(sbase + (unsigned)slot * ldb + (unsigned)(wc * 32 + 8 * fq) * 2u + bj * HALF * 2) = w; } } }
    }
};
struct EpiResid {
    static constexpr bool PERM = false, AFTER_DRAIN = false; static constexpr int BMAP = 0;
    const float* xs_lat; const float* xs_ctx; float* xd_lat; float* xd_ctx; const float* gate; int row_base; float* part;
    __device__ __forceinline__ void operator()(const f32x4 (&acc)[2][2][4][2], const Unit& u, int wr, int wc, int fr, int fq) const {
        const int rowt = row_base + u.pm * BM; const bool lat = rowt < ML;
        const int b = lat ? (rowt >> 11) : NB;
        const char* xs = (const char*)((lat ? xs_lat + (size_t)rowt * D : xs_ctx + (size_t)(rowt - ML) * D) + u.pn * BM);
        char* xd = (char*)((part != nullptr ? part + (size_t)u.kq * MC * D + (size_t)(rowt - ML) * D : lat ? xd_lat + (size_t)rowt * D : xd_ctx + (size_t)(rowt - ML) * D) + u.pn * BM);
        const char* gp = (const char*)(gate + (size_t)b * NMOD + u.pn * BM);
        const unsigned coff = (unsigned)(wc * 32 + 4 * fq) * 4u;
        unsigned off0 = (unsigned)(wr * 64 + fr) * (D * 4u) + coff; asm volatile("" : "+v"(off0));
#pragma unroll
        for (int bj = 0; bj < 2; ++bj)
#pragma unroll
            for (int n = 0; n < 2; ++n) { const f32x4 gv = *(const f32x4*)(gp + coff + (bj * HALF + n * 16) * 4);
#pragma unroll
                for (int ai = 0; ai < 2; ++ai) {
#pragma unroll
                    for (int m = 0; m < 4; ++m) { const unsigned off = off0 + (unsigned)((ai * HALF + m * 16) * D + bj * HALF + n * 16) * 4u;
                        if (part != nullptr) { *(f32x4*)(xd + off) = gv * acc[ai][bj][m][n]; }
                        else { const f32x4 xv = *(const f32x4*)(xs + off); *(f32x4*)(xd + off) = xv + gv * acc[ai][bj][m][n]; } }
                    } asm volatile("" ::: "memory"); }
    }
};

struct EpiRope {
    static constexpr bool PERM = false, AFTER_DRAIN = false; static constexpr int BMAP = 1;
    bf16_t* O; int ldc; int q_tiles;
    __device__ __forceinline__ void operator()(const f32x4 (&acc)[2][2][4][2], const Unit& u, int wr, int wc, int fr, int fq) const {
        char* base = (char*)(O + (size_t)(u.pm * BM) * ldc + u.pn * BM);
        const unsigned ldb = (unsigned)ldc * 2u; const float sc_ = (u.pn < q_tiles) ? 1.0f : 0.0625f;
        const int w0 = wc * 32 + 4 * fq;
        unsigned off0 = (unsigned)(wr * 64 + fr) * ldb + (unsigned)((w0 < 64 ? w0 : w0 + 64)) * 2u; asm volatile("" : "+v"(off0));
        float inv[2][4];
#pragma unroll
        for (int n = 0; n < 2; ++n)
#pragma unroll
            for (int j = 0; j < 4; ++j) inv[n][j] = __builtin_amdgcn_exp2f(-(float)((w0 + 16 * n + j) & 63) * (LOG2_THETA / 64.f)) * INV_2PI;
#pragma unroll
        for (int ai = 0; ai < 2; ++ai)
#pragma unroll
            for (int m = 0; m < 4; ++m) {
                int frl = fr; asm volatile("" : "+v"(frl));
                const int t = (u.pm * BM + ai * HALF + wr * 64 + m * 16 + frl) & (SEQ - 1);
                const float pos = (wc >= 2) ? (float)(t & 63) : (float)(t >> 6);
                const unsigned off = off0 + (unsigned)(ai * HALF + m * 16) * ldb;
#pragma unroll
                for (int n = 0; n < 2; ++n) { float o1[4], o2[4];
#pragma unroll
                    for (int j = 0; j < 4; ++j) { float tr = pos * inv[n][j]; tr -= rintf(tr);
                        const float sn = __builtin_amdgcn_sinf(tr), cs = __builtin_amdgcn_cosf(tr);
                        const float x1 = acc[ai][0][m][n][j], x2 = acc[ai][1][m][n][j];
                        o1[j] = (x1 * cs - x2 * sn) * sc_; o2[j] = (x1 * sn + x2 * cs) * sc_; }
                    u32x2 a1, a2; a1.x = cvt_pk_bf16(o1[0], o1[1]); a1.y = cvt_pk_bf16(o1[2], o1[3]); a2.x = cvt_pk_bf16(o2[0], o2[1]); a2.y = cvt_pk_bf16(o2[2], o2[3]);
                    *(u32x2*)(base + off + n * 32) = a1; *(u32x2*)(base + off + n * 32 + 128) = a2; } }
    }
};

struct EpiQKV {
    static constexpr bool PERM = false, AFTER_DRAIN = false; static constexpr int BMAP = 2;
    bf16_t* O; const float* qg; const float* kg;
    __device__ __forceinline__ void operator()(const f32x4 (&acc)[2][2][4][2], const Unit& u, int wr, int wc, int fr, int fq) const {
        constexpr int ldc = 1536;
        char* base = (char*)(O + (size_t)(u.pm * BM) * ldc + u.pn * BM + wc * 64);
        const unsigned ldb = (unsigned)ldc * 2u;
        unsigned off0 = (unsigned)(wr * 64 + fr) * ldb + (unsigned)(4 * fq) * 2u; asm volatile("" : "+v"(off0));
        const bool isv = u.pn == 5, isq = u.pn < 4, lat = u.pm < ML / BM;
        const float osc = isq ? C2 : 1.0f;
        const float* gp = isq ? qg : kg;
        float inv[4];
#pragma unroll
        for (int j = 0; j < 4; ++j) inv[j] = __builtin_amdgcn_exp2f(-(float)(4 * fq + j) * (LOG2_THETA / 16.f)) * INV_2PI;
#pragma unroll
        for (int ai = 0; ai < 2; ++ai)
#pragma unroll
            for (int m = 0; m < 4; ++m) {
                const unsigned off = off0 + (unsigned)(ai * HALF + m * 16) * ldb;
                float rstd = 1.0f;
                if (!isv) {
                    float ss = 0.f;
#pragma unroll
                    for (int n = 0; n < 2; ++n) { const f32x4 p = acc[ai][0][m][n], q = acc[ai][1][m][n];
                        ss += ((p[0] * p[0] + p[1] * p[1]) + (p[2] * p[2] + p[3] * p[3])) + ((q[0] * q[0] + q[1] * q[1]) + (q[2] * q[2] + q[3] * q[3])); }
                    ss += __shfl_xor(ss, 16); ss += __shfl_xor(ss, 32);
                    rstd = __builtin_amdgcn_rsqf(ss * (1.f / 64.f) + EPS);
                }
                int frl = fr; asm volatile("" : "+v"(frl));
                const int t = (u.pm * BM + ai * HALF + wr * 64 + m * 16 + frl) & (SEQ - 1);
#pragma unroll
                for (int n = 0; n < 2; ++n) {
                    f32x4 x1 = acc[ai][0][m][n], x2 = acc[ai][1][m][n];
                    if (!isv) {
                        x1 = x1 * rstd * *(const f32x4*)(gp + 32 * n + 4 * fq); x2 = x2 * rstd * *(const f32x4*)(gp + 32 * n + 4 * fq + 16);
                        if (lat) { const float pos = n ? (float)(t & 63) : (float)(t >> 6);
#pragma unroll
                            for (int j = 0; j < 4; ++j) { float tr = pos * inv[j]; tr -= rintf(tr);
                                const float sn = __builtin_amdgcn_sinf(tr), cs = __builtin_amdgcn_cosf(tr);
                                const float a1 = x1[j], a2 = x2[j]; x1[j] = a1 * cs - a2 * sn; x2[j] = a1 * sn + a2 * cs; } }
                        x1 = x1 * osc; x2 = x2 * osc;
                    }
                    u32x2 a1, a2; a1.x = cvt_pk_bf16(x1[0], x1[1]); a1.y = cvt_pk_bf16(x1[2], x1[3]); a2.x = cvt_pk_bf16(x2[0], x2[1]); a2.y = cvt_pk_bf16(x2[2], x2[3]);
                    *(u32x2*)(base + off + n * 64) = a1; *(u32x2*)(base + off + n * 64 + 32) = a2; }
                asm volatile("" ::: "memory"); }
    }
};

struct EpiGate {
    static constexpr bool PERM = true, AFTER_DRAIN = false; static constexpr int BMAP = 3;
    bf16_t* A2; bf16_t* side; const float* fk; const float* fb;
    __device__ __forceinline__ void operator()(const f32x4 (&acc)[2][2][4][2], const Unit& u, int wr, int wc, int fr_in, int fq_in) const {
        const int fr0_ = fr_in, fq0_ = fq_in;
        char* base = (char*)(A2 + (size_t)(u.pm * BM) * DFF);
        char* sbase = (char*)(side + (size_t)(u.pm * 16) * DFF2);
        int fr_l = fr0_, fq_l = fq0_; asm volatile("" : "+v"(fr_l), "+v"(fq_l));
        const int fr = fr_l, fq = fq_l;
        const int ch0 = u.pn * HALF + wc * 32 + 8 * fq;
        const unsigned off0 = (unsigned)(wr * 64 + fr) * (DFF * 2u) + (unsigned)ch0 * 2u;
        const bool f0 = fr == 0, f15 = fr == 15;
#define DPP_UP(v) __int_as_float(__builtin_amdgcn_update_dpp(0, __float_as_int(v), 0x121, 0xf, 0xf, false))
#define DPP_DN(v) __int_as_float(__builtin_amdgcn_update_dpp(0, __float_as_int(v), 0x12F, 0xf, 0xf, false))
#pragma unroll
        for (int ai = 0; ai < 2; ++ai) {
            f32x4 o[4]; u32x2 wlo[4];
#pragma unroll
            for (int n = 0; n < 2; ++n) {
                const int ch = ch0 + 4 * n;
#pragma unroll
                for (int pass = 0; pass < 2; ++pass) {
                    const int co = pass ? DFF : 0;
                    const f32x4 k0 = *(const f32x4*)(fk + co + ch), k1 = *(const f32x4*)(fk + DFF2 + co + ch), k2 = *(const f32x4*)(fk + 2 * DFF2 + co + ch), bb = *(const f32x4*)(fb + co + ch);
                    f32x4 up_prev = (f32x4){0.f, 0.f, 0.f, 0.f}, up_cur, dn_cur, dn_next;
#pragma unroll
                    for (int j = 0; j < 4; ++j) dn_cur[j] = DPP_DN(acc[ai][pass][0][n][j]);
#pragma unroll
                    for (int m = 0; m < 4; ++m) {
                        const f32x4 xv = acc[ai][pass][m][n];
#pragma unroll
                        for (int j = 0; j < 4; ++j) { up_cur[j] = DPP_UP(xv[j]); dn_next[j] = (m < 3) ? DPP_DN(acc[ai][pass][m < 3 ? m + 1 : 3][n][j]) : 0.f; }
                        const f32x4 xp = f0 ? up_prev : up_cur, xn = f15 ? dn_next : dn_cur;
                        const f32x4 c = (k0 * xp + k1 * xv) + (k2 * xn + bb);
                        if (pass == 0) o[m] = c;
                        else { f32x4 e;
#pragma unroll
                            for (int j = 0; j < 4; ++j) e[j] = __builtin_amdgcn_rcpf(1.0f + __builtin_amdgcn_exp2f(c[j] * -1.4426950408889634f));
                            o[m] = o[m] * (c * e); }
                        up_prev = up_cur; dn_cur = dn_next; }
                }
                if (n == 0) {
#pragma unroll
                    for (int m = 0; m < 4; ++m) { wlo[m].x = cvt_pk_bf16(o[m][0], o[m][1]); wlo[m].y = cvt_pk_bf16(o[m][2], o[m][3]); }
                } else {
#pragma unroll
                    for (int m = 0; m < 4; ++m) { u32x4 w; w.x = wlo[m].x; w.y = wlo[m].y; w.z = cvt_pk_bf16(o[m][0], o[m][1]); w.w = cvt_pk_bf16(o[m][2], o[m][3]);
                        *(u32x4*)(base + off0 + (unsigned)(ai * HALF + m * 16) * (DFF * 2u)) = w; }
                }
                if (fr < 2 || fr >= 14) { const int k = fr < 2 ? fr : fr - 12;
                    const f32x4 xv = fr < 2 ? acc[ai][0][0][n] : acc[ai][0][3][n], yv = fr < 2 ? acc[ai][1][0][n] : acc[ai][1][3][n];
                    char* sp = sbase + (size_t)((2 * ai + wr) * 4 + k) * (DFF2 * 2) + (size_t)ch * 2;
                    u32x2 a, b; a.x = cvt_pk_bf16(xv[0], xv[1]); a.y = cvt_pk_bf16(xv[2], xv[3]); b.x = cvt_pk_bf16(yv[0], yv[1]); b.y = cvt_pk_bf16(yv[2], yv[3]);
                    *(u32x2*)sp = a; *(u32x2*)(sp + DFF * 2) = b; }
            }
        }
#undef DPP_UP
#undef DPP_DN
    }
};

struct EpiResidNorm {
    static constexpr bool PERM = false, AFTER_DRAIN = true; static constexpr int BMAP = 0;
    const float* xs; float* xd; const float* gate;
    const float* gain; const float* modn; int shoff, scoff;
    bf16_t* H; unsigned* xbuf; unsigned* cnt; int fin;
    __device__ __forceinline__ void operator()(const f32x4 (&)[2][2][4][2], const Unit&, int, int, int, int) const {}
    __device__ __forceinline__ void fused(f32x4 (&acc)[2][2][4][2], const Unit& u, int wr, int wc, int fr, int fq, ldsp lds, int wid, int lane) const {
        const int rowt = u.pm * BM, b = rowt >> 11;
        const char* xsb = (const char*)(xs + (size_t)rowt * D + u.pn * BM);
        char* xdb = (char*)(xd + (size_t)rowt * D + u.pn * BM);
        const char* gp = (const char*)(gate + (size_t)b * NMOD + u.pn * BM);
        const unsigned coff = (unsigned)(wc * 32 + 4 * fq) * 4u;
        unsigned off0 = (unsigned)(wr * 64 + fr) * (D * 4u) + coff; asm volatile("" : "+v"(off0));
#pragma unroll
        for (int bj = 0; bj < 2; ++bj)
#pragma unroll
            for (int n = 0; n < 2; ++n) { const f32x4 gv = *(const f32x4*)(gp + coff + (bj * HALF + n * 16) * 4);
#pragma unroll
                for (int ai = 0; ai < 2; ++ai) {
#pragma unroll
                    for (int m = 0; m < 4; ++m) { const unsigned off = off0 + (unsigned)((ai * HALF + m * 16) * D + bj * HALF + n * 16) * 4u;
                        const f32x4 xv = *(const f32x4*)(xsb + off); acc[ai][bj][m][n] = xv + gv * acc[ai][bj][m][n];
                        if (!fin) *(f32x4*)(xdb + off) = acc[ai][bj][m][n]; }
                    asm volatile("" ::: "memory"); } }
        LAS float* P = (LAS float*)lds;
        LAS float* Sx = (LAS float*)(lds + 4096);
#pragma unroll
        for (int ai = 0; ai < 2; ++ai)
#pragma unroll
            for (int m = 0; m < 4; ++m) { float sq = 0.f;
#pragma unroll
                for (int bj = 0; bj < 2; ++bj)
#pragma unroll
                    for (int n = 0; n < 2; ++n) { const f32x4 v = acc[ai][bj][m][n]; sq += (v[0] * v[0] + v[1] * v[1]) + (v[2] * v[2] + v[3] * v[3]); }
                sq += __shfl_xor(sq, 16); sq += __shfl_xor(sq, 32);
                if (fq == 0) P[(ai * HALF + wr * 64 + m * 16 + fr) * 4 + wc] = sq; }
        asm volatile("s_waitcnt lgkmcnt(0)" ::: "memory"); __builtin_amdgcn_s_barrier(); asm volatile("" ::: "memory");
        const int row = wid * 32 + (lane & 31);
        unsigned* slot = xbuf + ((size_t)(u.pm * BM + row)) * 4;
        if (lane < 32) { const float t = ((P[row * 4 + 0] + P[row * 4 + 1]) + P[row * 4 + 2]) + P[row * 4 + 3];
            __hip_atomic_store(slot + u.pn, __float_as_uint(t), __ATOMIC_RELAXED, __HIP_MEMORY_SCOPE_AGENT); }
        asm volatile("s_waitcnt vmcnt(0)" ::: "memory");
        if (lane == 0) __hip_atomic_fetch_add(cnt + 64 * u.pm, 1u, __ATOMIC_RELAXED, __HIP_MEMORY_SCOPE_AGENT);
        if (wid == 0) { unsigned sp = 0u;
            while ((unsigned)__builtin_amdgcn_readfirstlane(__hip_atomic_load(cnt + 64 * u.pm, __ATOMIC_RELAXED, __HIP_MEMORY_SCOPE_AGENT)) < 32u) { __builtin_amdgcn_s_sleep(2); if (++sp > (1u << 22)) break; }
            __builtin_amdgcn_fence(__ATOMIC_ACQUIRE, "agent"); }
        asm volatile("s_waitcnt vmcnt(0) lgkmcnt(0)" ::: "memory"); __builtin_amdgcn_s_barrier(); asm volatile("" ::: "memory");
        if (lane < 32) {
            const float t0 = __uint_as_float(__hip_atomic_load(slot + 0, __ATOMIC_RELAXED, __HIP_MEMORY_SCOPE_AGENT)), t1 = __uint_as_float(__hip_atomic_load(slot + 1, __ATOMIC_RELAXED, __HIP_MEMORY_SCOPE_AGENT));
            const float t2 = __uint_as_float(__hip_atomic_load(slot + 2, __ATOMIC_RELAXED, __HIP_MEMORY_SCOPE_AGENT)), t3 = __uint_as_float(__hip_atomic_load(slot + 3, __ATOMIC_RELAXED, __HIP_MEMORY_SCOPE_AGENT));
            Sx[row] = 1.0f / sqrtf((((t0 + t1) + t2) + t3) * (1.f / D) + EPS); }
        asm volatile("s_waitcnt vmcnt(0) lgkmcnt(0)" ::: "memory"); __builtin_amdgcn_s_barrier(); asm volatile("" ::: "memory");
        const int colt = u.pn * BM + wc * 32 + 4 * fq;
        const float* mb = modn + (size_t)b * NMOD;
#pragma unroll
        for (int bj = 0; bj < 2; ++bj)
#pragma unroll
            for (int n = 0; n < 2; ++n) { const int c = colt + bj * HALF + n * 16;
                f32x4 gc = *(const f32x4*)(gain + c), sh = (f32x4){0.f, 0.f, 0.f, 0.f};
                if (!fin) { gc = gc * (*(const f32x4*)(mb + scoff + c) + 1.0f); sh = *(const f32x4*)(mb + shoff + c); }
#pragma unroll
                for (int ai = 0; ai < 2; ++ai)
#pragma unroll
                    for (int m = 0; m < 4; ++m) { const int r = ai * HALF + wr * 64 + m * 16 + fr; const float rs = Sx[r];
                        const f32x4 y = (acc[ai][bj][m][n] * rs) * gc + sh;
                        if (fin) *(f32x4*)(xd + (size_t)(rowt + r) * D + c) = y;
                        else { u32x2 w; w.x = cvt_pk_bf16(y[0], y[1]); w.y = cvt_pk_bf16(y[2], y[3]); *(u32x2*)(H + (size_t)(rowt + r) * D + c) = w; } } }
        asm volatile("s_waitcnt lgkmcnt(0)" ::: "memory"); __builtin_amdgcn_s_barrier(); asm volatile("" ::: "memory");
    }
};

template <class Epi>
__device__ __forceinline__ void gemm_phase(ldsp lds, const Gemm g, const StaticOrder& S, const Epi& E, const int tid) {
    const int wid = __builtin_amdgcn_readfirstlane(tid >> 6), lane = tid & 63, wr = wid >> 2, wc = wid & 3, fr = lane & 15, fq = lane >> 4;
    const int K = g.K, nt = K / BK, lda = g.lda;
    unsigned voffA[2], voffB[2];
#pragma unroll
    for (int i = 0; i < 2; ++i) { int R, C; stage_rc(tid * 16 + i * 8192, R, C); const int Rb = Epi::PERM ? ((R & ~31) + perm32(R & 31)) : (Epi::BMAP == 1 ? (R + (R >= 64 ? 64 : 0)) : Epi::BMAP == 2 ? ((R >> 5) * 64 + (R & 15) + ((R & 16) ? 32 : 0)) : R);
        voffA[i] = (unsigned)(R * lda + C) * 2u; voffB[i] = (unsigned)(Rb * g.ldb + C) * 2u; }
    const size_t kstep = (size_t)(BK * 2);
    const size_t hstepA = (size_t)HALF * lda * 2, hstepB = (size_t)(Epi::BMAP == 1 ? 64 : Epi::BMAP == 2 ? 16 : Epi::BMAP == 3 ? DFF : HALF) * g.ldb * 2;
    const size_t tstepA = 2 * hstepA, tstepB = (size_t)(Epi::BMAP == 3 ? HALF : BM) * g.ldb * 2;
    const unsigned ldsw = (unsigned)wid * 1024u;
    const int aoff = lds_byte(wr * 64 + fr, fq * 8), boff = lds_byte(wc * 32 + fr, fq * 8);
#define PG8_SA(b, h) (((b) * 2 + (h)) * HTB)
#define PG8_SB(b, h) ((4 + (b) * 2 + (h)) * HTB)
#define PG8_STAGE(bufoff, gbase, voff) do { _Pragma("unroll") for (int _i = 0; _i < 2; ++_i) \
        __builtin_amdgcn_global_load_lds((const unsigned*)((const char*)(gbase) + (voff)[_i]), (LAS unsigned*)(lds + (bufoff) + ldsw + _i * 8192), 16, 0, 0); } while (0)
#define PG8_LDA(dst, b, h) do { _Pragma("unroll") for (int m = 0; m < 4; ++m) _Pragma("unroll") for (int k = 0; k < 2; ++k) dst[m][k] = *(const LAS bf16x8*)(lds + PG8_SA(b, h) + aoff + m * 2048 + k * 1024); } while (0)
#define PG8_LDB(dst, b, h) do { _Pragma("unroll") for (int n = 0; n < 2; ++n) _Pragma("unroll") for (int k = 0; k < 2; ++k) dst[n][k] = *(const LAS bf16x8*)(lds + PG8_SB(b, h) + boff + n * 2048 + k * 1024); } while (0)
#define PG8_MMA(ai, bj, At, Bt) do { __builtin_amdgcn_s_setprio(1); _Pragma("unroll") for (int m = 0; m < 4; ++m) _Pragma("unroll") for (int n = 0; n < 2; ++n) _Pragma("unroll") for (int k = 0; k < 2; ++k) \
        acc[ai][bj][m][n] = __builtin_amdgcn_mfma_f32_16x16x32_bf16(Bt[n][k], At[m][k], acc[ai][bj][m][n], 0, 0, 0); __builtin_amdgcn_s_setprio(0); } while (0)
#define PG8_WAIT_V(n) asm volatile("s_waitcnt vmcnt(" #n ")" ::: "memory")
#define PG8_WAIT_L(n) asm volatile("s_waitcnt lgkmcnt(" #n ")" ::: "memory")
#define PG8_BAR __builtin_amdgcn_s_barrier()
#define PG8_SCHED __builtin_amdgcn_sched_barrier(0)
    Unit cur, nxt; int ui = 0;
    if (!S.next(0, cur)) return;
    f32x4 acc[2][2][4][2];
#pragma unroll
    for (int a = 0; a < 2; ++a)
#pragma unroll
        for (int b = 0; b < 2; ++b)
#pragma unroll
            for (int m = 0; m < 4; ++m)
#pragma unroll
                for (int n = 0; n < 2; ++n) acc[a][b][m][n] = (f32x4){0.f, 0.f, 0.f, 0.f};
    bf16x8 At[4][2], B0[2][2], B1[2][2];
    const char* cA = (const char*)g.A + (size_t)cur.pm * tstepA + cur.koff; const char* cB = (const char*)g.Bt + (size_t)cur.pn * tstepB + cur.koff;
    PG8_STAGE(PG8_SB(0, 0), cB, voffB); PG8_STAGE(PG8_SB(0, 1), cB + hstepB, voffB); PG8_STAGE(PG8_SA(0, 0), cA, voffA); PG8_STAGE(PG8_SA(0, 1), cA + hstepA, voffA);
    if (wr == 1) PG8_BAR;
    PG8_WAIT_V(2); PG8_BAR;
    PG8_STAGE(PG8_SB(1, 0), cB + kstep, voffB); PG8_STAGE(PG8_SA(1, 0), cA + kstep, voffA); PG8_STAGE(PG8_SB(1, 1), cB + hstepB + kstep, voffB);
    PG8_WAIT_V(6); PG8_BAR;
    for (;;) {
        const bool has_next = S.next(ui + 1, nxt);
        const char* nA = has_next ? (const char*)g.A + (size_t)nxt.pm * tstepA + nxt.koff : cA; const char* nB = has_next ? (const char*)g.Bt + (size_t)nxt.pn * tstepB + nxt.koff : cB;
        for (int t = 0; t < nt; t += 2) {
            const bool last = (t == nt - 2);
            const char* a1 = cA + (size_t)(t + 1) * kstep;
            const char* a2 = last ? nA : cA + (size_t)(t + 2) * kstep; const char* b2 = last ? nB : cB + (size_t)(t + 2) * kstep;
            const char* a3 = a2 + kstep; const char* b3 = b2 + kstep;
            PG8_LDB(B0, 0, 0); PG8_LDB(B1, 0, 1); PG8_SCHED; PG8_LDA(At, 0, 0); PG8_STAGE(PG8_SA(1, 1), a1 + hstepA, voffA);
            PG8_WAIT_V(8); PG8_WAIT_L(0); PG8_BAR; PG8_MMA(0, 0, At, B0); PG8_MMA(0, 1, At, B1); PG8_BAR; PG8_SCHED;
            PG8_LDA(At, 0, 1); PG8_STAGE(PG8_SB(0, 0), b2, voffB); PG8_STAGE(PG8_SB(0, 1), b2 + hstepB, voffB); PG8_STAGE(PG8_SA(0, 0), a2, voffA);
            PG8_WAIT_V(8); PG8_WAIT_L(0); PG8_BAR; PG8_MMA(1, 0, At, B0); PG8_MMA(1, 1, At, B1); PG8_BAR; PG8_SCHED;
            PG8_LDB(B0, 1, 0); PG8_LDB(B1, 1, 1); PG8_SCHED; PG8_LDA(At, 1, 0); PG8_STAGE(PG8_SA(0, 1), a2 + hstepA, voffA);
            PG8_WAIT_V(8); PG8_WAIT_L(0); PG8_BAR; PG8_MMA(0, 0, At, B0); PG8_MMA(0, 1, At, B1); PG8_BAR; PG8_SCHED;
            PG8_LDA(At, 1, 1); PG8_STAGE(PG8_SB(1, 0), b3, voffB); PG8_STAGE(PG8_SB(1, 1), b3 + hstepB, voffB); PG8_STAGE(PG8_SA(1, 0), a3, voffA);
            PG8_WAIT_V(8); PG8_WAIT_L(0); PG8_BAR; PG8_MMA(1, 0, At, B0); PG8_MMA(1, 1, At, B1); PG8_BAR; PG8_SCHED;
        }
        if (wr == 0) PG8_BAR;
        if constexpr (!Epi::AFTER_DRAIN) E(acc, cur, wr, wc, fr, fq);
        if (!has_next) break;
#pragma unroll
        for (int a = 0; a < 2; ++a)
#pragma unroll
            for (int b = 0; b < 2; ++b)
#pragma unroll
                for (int m = 0; m < 4; ++m)
#pragma unroll
                    for (int n = 0; n < 2; ++n) acc[a][b][m][n] = (f32x4){0.f, 0.f, 0.f, 0.f};
        cur = nxt; cA = nA; cB = nB; ++ui;
        if (wr == 1) PG8_BAR;
    }
    PG8_WAIT_V(0);
    PG8_BAR;
    if constexpr (Epi::AFTER_DRAIN) E.fused(acc, cur, wr, wc, fr, fq, lds, wid, lane);
#undef PG8_SA
#undef PG8_SB
#undef PG8_STAGE
#undef PG8_LDA
#undef PG8_LDB
#undef PG8_MMA
#undef PG8_WAIT_V
#undef PG8_WAIT_L
#undef PG8_BAR
#undef PG8_SCHED
}
}

struct Args {
    const float *x, *c, *ctx, *c_ctx, *ada_w, *ada_b, *norm_mix_g, *norm_ffn_g, *final_g, *conv_w_in, *conv_k, *conv_w_out, *attn_w_qkv, *attn_qg, *attn_kg,
        *attn_w_out, *ret_w_in, *ret_decay, *ret_w_out, *ffn_w_up, *ffn_conv_k, *ffn_conv_b, *ffn_w_down;
    float* out; unsigned char* ws;
    int ph_lo, ph_hi, coop, pad;
};

__device__ __forceinline__ unsigned f2bf(float f) { unsigned u = __builtin_bit_cast(unsigned, f); return (u + 0x7fffu + ((u >> 16) & 1u)) >> 16; }
__device__ __forceinline__ unsigned pk2(float lo, float hi) { return f2bf(lo) | (f2bf(hi) << 16); }
__device__ __forceinline__ void transpose_item(const float* W, int K, int N, bf16_t* WT, LAS float* scr, int item, int lane) {
    const int nblk = N / 32, kb = item / nblk, nb = item % nblk, k0 = 64 * kb, n0 = 32 * nb;
    float wv[32];
#pragma unroll
    for (int i = 0; i < 32; ++i) wv[i] = W[(size_t)(k0 + 2 * i + (lane >> 5)) * N + n0 + (lane & 31)];
#pragma unroll
    for (int i = 0; i < 32; ++i) scr[(2 * i + (lane >> 5)) * 33 + (lane & 31)] = wv[i];
    asm volatile("s_waitcnt lgkmcnt(0)" ::: "memory");
    const int c = lane & 7;
#pragma unroll
    for (int j = 0; j < 4; ++j) { const int n = (lane >> 3) + 8 * j; const LAS float* s = scr + (8 * c) * 33 + n;
        u32x4 o; o.x = pk2(s[0 * 33], s[1 * 33]); o.y = pk2(s[2 * 33], s[3 * 33]); o.z = pk2(s[4 * 33], s[5 * 33]); o.w = pk2(s[6 * 33], s[7 * 33]);
        *(u32x4*)(WT + (size_t)(n0 + n) * K + k0 + 8 * c) = o; }
    asm volatile("s_waitcnt lgkmcnt(0)" ::: "memory");
}

__device__ __forceinline__ void transpose_flat(const __attribute__((address_space(4))) Args& a, LAS float* scr, int it, int lane) {
    unsigned char* ws = a.ws;
    const float* W; int K, N; bf16_t* WT;
    if (it < 3072) { const int mi = it / 1536; it -= mi * 1536; W = a.conv_w_in + (size_t)mi * D * 3072; K = D; N = 3072; WT = (bf16_t*)(ws + WS_CIN) + (size_t)mi * 3072 * D; }
    else if (it < 4096) { it -= 3072; const int mi = it / 512; it -= mi * 512; W = a.conv_w_out + (size_t)mi * D * D; K = D; N = D; WT = (bf16_t*)(ws + WS_COUT) + (size_t)mi * D * D; }
    else if (it < 4864) { it -= 4096; W = a.attn_w_qkv; K = D; N = 1536; WT = (bf16_t*)(ws + WS_AQKV); }
    else if (it < 5376) { it -= 4864; W = a.attn_w_out; K = D; N = D; WT = (bf16_t*)(ws + WS_AOUT); }
    else if (it < 8448) { it -= 5376; W = a.ret_w_in; K = D; N = 6144; WT = (bf16_t*)(ws + WS_RIN); }
    else if (it < 9472) { it -= 8448; W = a.ret_w_out; K = 2048; N = D; WT = (bf16_t*)(ws + WS_ROUT); }
    else if (it < 20736) { it -= 9472; const int mi = it / 2816; it -= mi * 2816; W = a.ffn_w_up + (size_t)mi * D * DFF2; K = D; N = DFF2; WT = (bf16_t*)(ws + WS_UP) + (size_t)mi * DFF2 * D; }
    else { it -= 20736; const int mi = it / 1408; it -= mi * 1408; W = a.ffn_w_down + (size_t)mi * DFF * D; K = DFF; N = D; WT = (bf16_t*)(ws + WS_DN) + (size_t)mi * D * DFF; }
    transpose_item(W, K, N, WT, scr, it, lane);
}
__device__ __forceinline__ void convert_set(const __attribute__((address_space(4))) Args& a, ldsp lds, int set, int w, int nw, int wave, int lane) {
    LAS float* scr = (LAS float*)(lds + wave * 8704);
    int s0, l0, s1, l1, s2, l2, s3, l3, s4, l4;
    if (set == 0) { s0 = 0; l0 = 1536; s1 = 3072; l1 = 512; s2 = 9472; l2 = 2816; s3 = 20736; l3 = 1408; s4 = 0; l4 = 0; }
    else if (set == 1) { s0 = 4096; l0 = 1280; s1 = 12288; l1 = 2816; s2 = 0; l2 = 0; s3 = 0; l3 = 0; s4 = 0; l4 = 0; }
    else if (set == 2) { s0 = 22144; l0 = 1408; s1 = 5376; l1 = 4096; s2 = 15104; l2 = 2816; s3 = 0; l3 = 0; s4 = 0; l4 = 0; }
    else { s0 = 23552; l0 = 1408; s1 = 1536; l1 = 1536; s2 = 3584; l2 = 512; s3 = 17920; l3 = 2816; s4 = 24960; l4 = 1408; }
    const int total = l0 + l1 + l2 + l3 + l4;
    for (int j = w; j < total; j += nw) {
        int r = j, it;
        if (r < l0) it = s0 + r; else { r -= l0;
            if (r < l1) it = s1 + r; else { r -= l1;
                if (r < l2) it = s2 + r; else { r -= l2;
                    if (r < l3) it = s3 + r; else it = s4 + (r - l3); } } }
        transpose_flat(a, scr, it, lane);
    }
}
__device__ __forceinline__ void prologue(const __attribute__((address_space(4))) Args& a, ldsp lds, int gw, int NGW, int wave, int lane, const int tid, const int bid, const int G) {
    LAS float* scr = (LAS float*)(lds + wave * 8704);
    unsigned char* ws = a.ws;
    convert_set(a, lds, 0, gw, NGW, wave, lane);
    if (G != 256) { for (int cs = 1; cs < 4; ++cs) convert_set(a, lds, cs, gw, NGW, wave, lane); }
    { const f32x4* src = (const f32x4*)a.ctx; f32x4* dst = (f32x4*)(ws + WS_XC); for (int i = gw * 64 + lane; i < MC * D / 4; i += NGW * 64) dst[i] = src[i]; }
    if (bid == 0 && tid < 8) ((float*)(ws + WS_MODS))[4 * 9 * NMOD + tid] = __builtin_amdgcn_logf(1.0f - __builtin_amdgcn_exp2f(-a.ret_decay[tid]));
    __syncthreads();
    LAS float* sc = (LAS float*)(lds + 69632);
    LAS float* red = (LAS float*)(lds + 106496);
    for (int i = tid; i < 9 * D; i += 512) { const float v = (i < 8 * D) ? a.c[i] : a.c_ctx[i - 8 * D]; sc[i] = silu_f(v); }
    __syncthreads();
    float* mods = (float*)(ws + WS_MODS);
    for (int u = bid; u < 4 * 96; u += G) {
        const int layer = u / 96, col0 = (u % 96) * 64;
        const float* Wl = a.ada_w + (size_t)layer * D * NMOD + col0 + lane;
        float acc[9];
#pragma unroll
        for (int j = 0; j < 9; ++j) acc[j] = 0.f;
        for (int k = wave * 128; k < wave * 128 + 128; k += 16) {
            float wv[16];
#pragma unroll
            for (int q = 0; q < 16; ++q) wv[q] = Wl[(size_t)(k + q) * NMOD];
#pragma unroll
            for (int q4 = 0; q4 < 4; ++q4)
#pragma unroll
                for (int j = 0; j < 9; ++j) { const f32x4 s4 = *(const LAS f32x4*)(sc + j * D + k + 4 * q4); acc[j] += s4[0] * wv[4 * q4] + s4[1] * wv[4 * q4 + 1] + s4[2] * wv[4 * q4 + 2] + s4[3] * wv[4 * q4 + 3]; }
        }
#pragma unroll
        for (int j = 0; j < 9; ++j) red[(wave * 9 + j) * 64 + lane] = acc[j];
        __syncthreads();
        for (int i = tid; i < 9 * 64; i += 512) { const int j = i >> 6, cc = i & 63; float s = a.ada_b[layer * NMOD + col0 + cc];
#pragma unroll
            for (int w = 0; w < 8; ++w) s += red[(w * 9 + j) * 64 + cc];
            mods[((size_t)layer * 9 + j) * NMOD + col0 + cc] = s; }
        __syncthreads();
    }
}

__device__ __forceinline__ void norm_phase(const float* xs_lat, const float* xs_ctx, const float* partA, const float* partB, float* xc_wr, int row_begin, int rows, const float* gain, const float* modl, int shoff, int scoff, bf16_t* H, int gw, int NGW, int lane) {
    for (int row0 = row_begin + gw; row0 < rows; row0 += 2 * NGW) {
        f32x4 v[2][4]; bool ok[2], latv[2];
#pragma unroll
        for (int u = 0; u < 2; ++u) { const int row = row0 + u * NGW; ok[u] = row < rows; const bool lat = row < ML; latv[u] = lat;
            if (ok[u]) { const f32x4* xr = (const f32x4*)(lat ? xs_lat + (size_t)row * D : xs_ctx + (size_t)(row - ML) * D) + lane;
#pragma unroll
                for (int j = 0; j < 4; ++j) v[u][j] = xr[64 * j]; } }
#pragma unroll
        for (int u = 0; u < 2; ++u) if (ok[u]) {
            const int row = row0 + u * NGW; const bool lat = latv[u]; const int b = lat ? (row >> 11) : NB;
            if (!lat && partA != nullptr) {
                const size_t ro = (size_t)(row - ML) * D;
#pragma unroll
                for (int j = 0; j < 4; ++j) { const int ix = 64 * j + lane;
                    v[u][j] = (((v[u][j] + ((const f32x4*)(partA + ro))[ix]) + ((const f32x4*)(partA + (size_t)MC * D + ro))[ix]) + ((const f32x4*)(partB + ro))[ix]) + ((const f32x4*)(partB + (size_t)MC * D + ro))[ix];
                    ((f32x4*)(xc_wr + ro))[ix] = v[u][j]; }
            }
            float s = 0.f;
#pragma unroll
            for (int j = 0; j < 4; ++j) s += (v[u][j][0] * v[u][j][0] + v[u][j][1] * v[u][j][1]) + (v[u][j][2] * v[u][j][2] + v[u][j][3] * v[u][j][3]);
            const float rstd = 1.0f / sqrtf(wave_sum(s) * (1.f / D) + EPS);
            const float* mb = modl + (size_t)b * NMOD;
            u32x2* o8 = (u32x2*)(H + (size_t)row * D) + lane;
#pragma unroll
            for (int j = 0; j < 4; ++j) { const int c = 4 * (lane + 64 * j);
                const f32x4 g4 = *(const f32x4*)(gain + c), sc4 = *(const f32x4*)(mb + scoff + c), sh4 = *(const f32x4*)(mb + shoff + c);
                const f32x4 y = (v[u][j] * rstd * g4) * (sc4 + 1.0f) + sh4;
                u32x2 w; w.x = cvt_pk_bf16(y[0], y[1]); w.y = cvt_pk_bf16(y[2], y[3]); o8[64 * j] = w; }
        }
    }
}
__device__ __forceinline__ void final_phase(float* x, const float* gain, int gw, int NGW, int lane) {
    for (int row0 = gw; row0 < ML; row0 += 2 * NGW) {
        f32x4 v[2][4];
#pragma unroll
        for (int u = 0; u < 2; ++u) { const f32x4* xr = (const f32x4*)(x + (size_t)(row0 + u * NGW) * D) + lane;
#pragma unroll
            for (int j = 0; j < 4; ++j) v[u][j] = xr[64 * j]; }
#pragma unroll
        for (int u = 0; u < 2; ++u) { f32x4* xr = (f32x4*)(x + (size_t)(row0 + u * NGW) * D) + lane; float s = 0.f;
#pragma unroll
            for (int j = 0; j < 4; ++j) s += (v[u][j][0] * v[u][j][0] + v[u][j][1] * v[u][j][1]) + (v[u][j][2] * v[u][j][2] + v[u][j][3] * v[u][j][3]);
            const float rstd = 1.0f / sqrtf(wave_sum(s) * (1.f / D) + EPS);
#pragma unroll
            for (int j = 0; j < 4; ++j) { const f32x4 g4 = *(const f32x4*)(gain + 4 * (lane + 64 * j)); xr[64 * j] = v[u][j] * rstd * g4; } }
    }
}
__device__ __forceinline__ void convgate_phase(const bf16_t* U, bf16_t* H, int rows, const float* ck, int gw, int NGW, int lane) {
    for (int row = gw; row < rows; row += NGW) {
        const bool lat = row < ML; const int t = lat ? (row & (SEQ - 1)) : ((row - ML) & (CL - 1)); const int L = lat ? SEQ : CL;
        const bool hasp = t > 0, hasn = t < L - 1;
        const bf16_t* ur = U + (size_t)row * 3072;
        u32x4 bq[2], cq[2], vq[2], cp[2], vp[2], cn[2], vn[2];
#pragma unroll
        for (int hf = 0; hf < 2; ++hf) {
            const int c0 = lane * 16 + hf * 8;
            bq[hf] = *(const u32x4*)(ur + c0); cq[hf] = *(const u32x4*)(ur + 1024 + c0); vq[hf] = *(const u32x4*)(ur + 2048 + c0);
            cp[hf] = (u32x4){0, 0, 0, 0}; vp[hf] = cp[hf]; cn[hf] = cp[hf]; vn[hf] = cp[hf];
            if (hasp) { cp[hf] = *(const u32x4*)(ur - 3072 + 1024 + c0); vp[hf] = *(const u32x4*)(ur - 3072 + 2048 + c0); }
            if (hasn) { cn[hf] = *(const u32x4*)(ur + 3072 + 1024 + c0); vn[hf] = *(const u32x4*)(ur + 3072 + 2048 + c0); }
        }
#pragma unroll
        for (int hf = 0; hf < 2; ++hf) {
            const int c0 = lane * 16 + hf * 8;
            u32x4 ow;
#pragma unroll
            for (int e = 0; e < 4; ++e) {
                const f32x2 w0 = *(const f32x2*)(ck + c0 + 2 * e), w1 = *(const f32x2*)(ck + D + c0 + 2 * e), w2 = *(const f32x2*)(ck + 2 * D + c0 + 2 * e);
                const float lo = bflo(bq[hf][e]) * (w0[0] * (bflo(cp[hf][e]) * bflo(vp[hf][e])) + w1[0] * (bflo(cq[hf][e]) * bflo(vq[hf][e])) + w2[0] * (bflo(cn[hf][e]) * bflo(vn[hf][e])));
                const float hi = bfhi(bq[hf][e]) * (w0[1] * (bfhi(cp[hf][e]) * bfhi(vp[hf][e])) + w1[1] * (bfhi(cq[hf][e]) * bfhi(vq[hf][e])) + w2[1] * (bfhi(cn[hf][e]) * bfhi(vn[hf][e])));
                ow[e] = cvt_pk_bf16(lo, hi);
            }
            *(u32x4*)(H + (size_t)row * D + c0) = ow;
        }
    }
}
__device__ __forceinline__ void ffngate_a(const bf16_t* U, bf16_t* SIDE, int rows, int gtid, int NTH) {
    const int n = (rows / 32) * 2 * 704;
    for (int i = gtid; i < n; i += NTH) { const int c8 = i % 704, cw = i / 704, row = 32 * (cw >> 1) + ((cw & 1) ? 31 : 0);
        *(u32x4*)(SIDE + (size_t)cw * DFF2 + c8 * 8) = *(const u32x4*)(U + (size_t)row * DFF2 + c8 * 8); }
}
__device__ __forceinline__ void ffngate_b(bf16_t* U, bf16_t* DST, size_t dmask, const bf16_t* SIDE, int rows, const float* fk, const float* fb, int gw, int NGW, int lane) {
    const int ntask = (rows / 32) * 11;
    for (int wt = gw; wt < ntask; wt += NGW) {
        const int c = wt / 11, s = wt % 11, ch = 256 * s + 4 * lane, r0 = 32 * c;
        const bool lat = r0 < ML; const int t0 = lat ? (r0 & (SEQ - 1)) : ((r0 - ML) & (CL - 1)); const int L = lat ? SEQ : CL;
        const bool first = (t0 == 0), lastc = (t0 + 32 == L);
        const f32x4 kv0 = *(const f32x4*)(fk + ch), kv1 = *(const f32x4*)(fk + DFF2 + ch), kv2 = *(const f32x4*)(fk + 2 * DFF2 + ch);
        const f32x4 kg0 = *(const f32x4*)(fk + DFF + ch), kg1 = *(const f32x4*)(fk + DFF2 + DFF + ch), kg2 = *(const f32x4*)(fk + 2 * DFF2 + DFF + ch);
        const f32x4 bv = *(const f32x4*)(fb + ch), bg = *(const f32x4*)(fb + DFF + ch);
        f32x4 pv = (f32x4){0.f, 0.f, 0.f, 0.f}, pg = pv, cv, cgt;
        if (!first) { const bf16_t* sp = SIDE + (size_t)((c - 1) * 2 + 1) * DFF2 + ch; const u32x2 a = *(const u32x2*)sp, b = *(const u32x2*)(sp + DFF);
            pv = (f32x4){bflo(a.x), bfhi(a.x), bflo(a.y), bfhi(a.y)}; pg = (f32x4){bflo(b.x), bfhi(b.x), bflo(b.y), bfhi(b.y)}; }
        { const bf16_t* up = U + (size_t)r0 * DFF2 + ch; const u32x2 a = *(const u32x2*)up, b = *(const u32x2*)(up + DFF);
            cv = (f32x4){bflo(a.x), bfhi(a.x), bflo(a.y), bfhi(a.y)}; cgt = (f32x4){bflo(b.x), bfhi(b.x), bflo(b.y), bfhi(b.y)}; }
        for (int rb = 0; rb < 4; ++rb) {
            u32x2 nv[8], ng[8];
#pragma unroll
            for (int i = 0; i < 8; ++i) { const int rr = 8 * rb + i + 1;
                const bf16_t* p = (rr < 32) ? U + (size_t)(r0 + rr) * DFF2 + ch : SIDE + (size_t)((lastc ? c : c + 1) * 2) * DFF2 + ch;
                nv[i] = *(const u32x2*)p; ng[i] = *(const u32x2*)(p + DFF); }
#pragma unroll
            for (int i = 0; i < 8; ++i) { const int rr = 8 * rb + i + 1;
                f32x4 xv = (f32x4){bflo(nv[i].x), bfhi(nv[i].x), bflo(nv[i].y), bfhi(nv[i].y)}, xg = (f32x4){bflo(ng[i].x), bfhi(ng[i].x), bflo(ng[i].y), bfhi(ng[i].y)};
                if (rr == 32 && lastc) { xv = (f32x4){0.f, 0.f, 0.f, 0.f}; xg = xv; }
                const f32x4 val = kv0 * pv + kv1 * cv + kv2 * xv + bv, gt = kg0 * pg + kg1 * cgt + kg2 * xg + bg;
                u32x2 w; w.x = cvt_pk_bf16(silu_f(gt[0]) * val[0], silu_f(gt[1]) * val[1]); w.y = cvt_pk_bf16(silu_f(gt[2]) * val[2], silu_f(gt[3]) * val[3]);
                *(u32x2*)(DST + (((size_t)(r0 + rr - 1) * DFF2 + ch) & dmask)) = w;
                pv = cv; pg = cgt; cv = xv; cgt = xg; }
        }
    }
}
__device__ __forceinline__ void ffngate_fix(bf16_t* A2, const bf16_t* side, int rows, const float* fk, const float* fb, int gw, int NGW, int lane) {
    const int ntask = (rows / 64) * 2 * 11;
    for (int wt = gw; wt < ntask; wt += NGW) {
        const int s = wt % 11, sw = wt / 11, last = sw & 1, G = sw >> 1, ch = 256 * s + 4 * lane;
        const int R = 64 * G + (last ? 63 : 0);
        const bool lat = R < ML; const int t = lat ? (R & (SEQ - 1)) : ((R - ML) & (CL - 1)); const int L = lat ? SEQ : CL;
        const bool hasp = t > 0, hasn = t < L - 1;
        const bf16_t* pc = side + (size_t)(G * 4 + (last ? 3 : 0)) * DFF2 + ch;
        const bf16_t* pp = last ? side + (size_t)(G * 4 + 2) * DFF2 + ch : side + (size_t)((G - 1) * 4 + 3) * DFF2 + ch;
        const bf16_t* pn = last ? side + (size_t)((G + 1) * 4 + 0) * DFF2 + ch : side + (size_t)(G * 4 + 1) * DFF2 + ch;
        u32x2 cv = *(const u32x2*)pc, cg = *(const u32x2*)(pc + DFF), pv = (u32x2){0u, 0u}, pg = pv, nv = pv, ng = pv;
        if (hasp) { pv = *(const u32x2*)pp; pg = *(const u32x2*)(pp + DFF); }
        if (hasn) { nv = *(const u32x2*)pn; ng = *(const u32x2*)(pn + DFF); }
        const f32x4 kv0 = *(const f32x4*)(fk + ch), kv1 = *(const f32x4*)(fk + DFF2 + ch), kv2 = *(const f32x4*)(fk + 2 * DFF2 + ch), bv = *(const f32x4*)(fb + ch);
        const f32x4 kg0 = *(const f32x4*)(fk + DFF + ch), kg1 = *(const f32x4*)(fk + DFF2 + DFF + ch), kg2 = *(const f32x4*)(fk + 2 * DFF2 + DFF + ch), bg = *(const f32x4*)(fb + DFF + ch);
#define UNP(w) (f32x4){bflo((w).x), bfhi((w).x), bflo((w).y), bfhi((w).y)}
        const f32x4 val = kv0 * UNP(pv) + kv1 * UNP(cv) + kv2 * UNP(nv) + bv, gt = kg0 * UNP(pg) + kg1 * UNP(cg) + kg2 * UNP(ng) + bg;
#undef UNP
        u32x2 w; w.x = cvt_pk_bf16(silu_f(gt[0]) * val[0], silu_f(gt[1]) * val[1]); w.y = cvt_pk_bf16(silu_f(gt[2]) * val[2], silu_f(gt[3]) * val[3]);
        *(u32x2*)(A2 + (size_t)R * DFF + ch) = w;
    }
}
__device__ __forceinline__ void attnprep_phase(bf16_t* QKV, const float* qg, const float* kg, int gw, int NGW, int lane) {
    for (int row = gw; row < MT; row += NGW) {
        const bool lat = row < ML; const int t = row & (SEQ - 1);
        const float pos = (lane & 2) ? (float)(t & 63) : (float)(t >> 6);
#pragma unroll
        for (int part = 0; part < 2; ++part) {
            const bool act = part == 0 || lane < 16;
            bf16_t* p = QKV + (size_t)row * 1536 + (part ? 1024 : 0) + (act ? lane * 16 : 0);
            const u32x4 r0 = *(const u32x4*)p, r1 = *(const u32x4*)(p + 8);
            float v[16];
#pragma unroll
            for (int e = 0; e < 4; ++e) { v[2 * e] = bflo(r0[e]); v[2 * e + 1] = bfhi(r0[e]); v[8 + 2 * e] = bflo(r1[e]); v[8 + 2 * e + 1] = bfhi(r1[e]); }
            float ss = 0.f;
#pragma unroll
            for (int e = 0; e < 16; ++e) ss += v[e] * v[e];
            ss += __shfl_xor(ss, 1); ss += __shfl_xor(ss, 2);
            const float rstd = 1.0f / sqrtf(ss * (1.f / 64.f) + EPS);
            const float* gp = (part ? kg : qg) + (lane & 3) * 16;
            const float osc = part ? 1.0f : C2;
            u32x4 o0, o1;
#pragma unroll
            for (int e = 0; e < 16; e += 2) {
                float y[2];
#pragma unroll
                for (int q = 0; q < 2; ++q) {
                    const float mine = v[e + q] * rstd * gp[e + q];
                    const float other = __shfl_xor(mine, 1);
                    float r = mine;
                    if (lat) {
                        const float ang = pos * __builtin_amdgcn_exp2f(-(float)(e + q) * (LOG2_THETA / 16.f));
                        float tr = ang * INV_2PI; tr -= rintf(tr);
                        const float sn = __builtin_amdgcn_sinf(tr), cs = __builtin_amdgcn_cosf(tr);
                        r = (lane & 1) ? (other * sn + mine * cs) : (mine * cs - other * sn);
                    }
                    y[q] = r * osc;
                }
                const unsigned w = cvt_pk_bf16(y[0], y[1]);
                if (e < 8) o0[e >> 1] = w; else o1[(e - 8) >> 1] = w;
            }
            if (act) { *(u32x4*)p = o0; *(u32x4*)(p + 8) = o1; }
        }
    }
}
__device__ __forceinline__ void retprep_phase(bf16_t* R, bf16_t* RC, int gw, int NGW, int lane) {
    for (int row = gw; row < MT; row += NGW) {
        const bool lat = row < ML;
        if (lat) {
            const int t = row & (SEQ - 1);
            const float pos = (lane & 8) ? (float)(t & 63) : (float)(t >> 6);
#pragma unroll
            for (int part = 0; part < 2; ++part) {
                bf16_t* p = R + (size_t)row * 6144 + part * 1024 + lane * 16;
                const u32x4 r0 = *(const u32x4*)p, r1 = *(const u32x4*)(p + 8);
                float v[16];
#pragma unroll
                for (int e = 0; e < 4; ++e) { v[2 * e] = bflo(r0[e]); v[2 * e + 1] = bfhi(r0[e]); v[8 + 2 * e] = bflo(r1[e]); v[8 + 2 * e + 1] = bfhi(r1[e]); }
                const float osc = part ? 0.0625f : 1.0f;
                u32x4 o0, o1;
#pragma unroll
                for (int e = 0; e < 16; e += 2) {
                    float y[2];
#pragma unroll
                    for (int q = 0; q < 2; ++q) {
                        const float mine = v[e + q];
                        const float other = __shfl_xor(mine, 4);
                        const float ang = pos * __builtin_amdgcn_exp2f(-(float)((lane & 3) * 16 + e + q) * (LOG2_THETA / 64.f));
                        float tr = ang * INV_2PI; tr -= rintf(tr);
                        const float sn = __builtin_amdgcn_sinf(tr), cs = __builtin_amdgcn_cosf(tr);
                        y[q] = ((lane & 4) ? (other * sn + mine * cs) : (mine * cs - other * sn)) * osc;
                    }
                    const unsigned w = cvt_pk_bf16(y[0], y[1]);
                    if (e < 8) o0[e >> 1] = w; else o1[(e - 8) >> 1] = w;
                }
                *(u32x4*)p = o0; *(u32x4*)(p + 8) = o1;
            }
        } else {
            bf16_t* p = RC + (size_t)(row - ML) * 3072 + lane * 16;
            const u32x4 r0 = *(const u32x4*)p, r1 = *(const u32x4*)(p + 8);
            u32x4 o0, o1;
#pragma unroll
            for (int e = 0; e < 4; ++e) { o0[e] = cvt_pk_bf16(bflo(r0[e]) * 0.0625f, bfhi(r0[e]) * 0.0625f); o1[e] = cvt_pk_bf16(bflo(r1[e]) * 0.0625f, bfhi(r1[e]) * 0.0625f); }
            *(u32x4*)p = o0; *(u32x4*)(p + 8) = o1;
        }
    }
}

namespace attn_body {
using bf16=__hip_bfloat16;
using bf16x8=__attribute__((ext_vector_type(8)))short;
using s16x4=__attribute__((ext_vector_type(4)))short;
using f32x16=__attribute__((ext_vector_type(16)))float;
using u32x4=__attribute__((ext_vector_type(4)))unsigned;
constexpr int D=64,QP=1536,OP=1024;
constexpr int NW=8,QBLK=32,QB=QBLK*NW,KVBLK=64;
__device__ __forceinline__ int crow(int r,int hi){return (r&3)+8*(r>>2)+4*hi;}
#define SBAR() __builtin_amdgcn_sched_barrier(0)
constexpr int NSLOT=3, SLOTB=8192;
constexpr int LDS_K=0, LDS_V=NSLOT*SLOTB, LDS_WS=2*NSLOT*SLOTB, LDS_OST=LDS_WS+NW*64*4, LDS_BYTES=LDS_OST+NW*4096;
constexpr float C2=0.125f*1.4426950408889634f;
__device__ __forceinline__ void glds16(const void*gsrc,unsigned lds_dst){unsigned keep;
  asm volatile("s_mov_b32 %0, m0\n\ts_mov_b32 m0, %2\n\ts_nop 0\n\tglobal_load_lds_dwordx4 %1, off\n\ts_mov_b32 m0, %0":"=&s"(keep):"v"(gsrc),"s"(lds_dst):"memory");}
__device__ __forceinline__ float max3f(float a,float b,float c){float r;asm("v_max3_f32 %0, %1, %2, %3":"=v"(r):"v"(a),"v"(b),"v"(c));return r;}
__device__ __forceinline__ float max2f(float a,float b){float r;asm("v_max_f32_e32 %0, %1, %2":"=v"(r):"v"(a),"v"(b));return r;}
__device__ __forceinline__ float fadd_s(float a,float b){float r;asm("v_add_f32_e32 %0, %1, %2":"=v"(r):"v"(a),"v"(b));return r;}
__device__ __forceinline__ float fsub_s(float a,float b){float r;asm("v_sub_f32_e32 %0, %1, %2":"=v"(r):"v"(a),"v"(b));return r;}
typedef float f32x2_t __attribute__((ext_vector_type(2))); typedef __bf16 bf16x2_t __attribute__((ext_vector_type(2)));
__device__ __forceinline__ unsigned cvtpk_s(float lo,float hi){f32x2_t v={lo,hi};bf16x2_t b=__builtin_convertvector(v,bf16x2_t);return __builtin_bit_cast(unsigned,b);}
#define WAIT_BAR(N) asm volatile("s_waitcnt vmcnt(" #N ") lgkmcnt(0)\n\ts_barrier":::"memory")

__device__ __forceinline__ void qkt(f32x16&p0,f32x16&p1,const char*Kslot,const bf16x8*qr,const f32x16&negm,int r32,int hi){
  const char*kb=Kslot+hi*1024+r32*16;
  #pragma unroll
  for(int d0=0;d0<4;++d0){
    const bf16x8 b0=*reinterpret_cast<const bf16x8*>(kb+d0*2048);
    const bf16x8 b1=*reinterpret_cast<const bf16x8*>(kb+d0*2048+512);
    if(d0==0){p0=__builtin_amdgcn_mfma_f32_32x32x16_bf16(b0,qr[0],negm,0,0,0);p1=__builtin_amdgcn_mfma_f32_32x32x16_bf16(b1,qr[0],negm,0,0,0);}
    else{p0=__builtin_amdgcn_mfma_f32_32x32x16_bf16(b0,qr[d0],p0,0,0,0);p1=__builtin_amdgcn_mfma_f32_32x32x16_bf16(b1,qr[d0],p1,0,0,0);}}
}
typedef __attribute__((address_space(3))) const char* lds_cptr;
typedef short v4i16_t __attribute__((ext_vector_type(4)));
__device__ __forceinline__ void kload8(bf16x8*kf,lds_cptr kp){
  kf[0]=*(const __attribute__((address_space(3))) bf16x8*)(kp);      kf[1]=*(const __attribute__((address_space(3))) bf16x8*)(kp+512);
  kf[2]=*(const __attribute__((address_space(3))) bf16x8*)(kp+2048); kf[3]=*(const __attribute__((address_space(3))) bf16x8*)(kp+2560);
  kf[4]=*(const __attribute__((address_space(3))) bf16x8*)(kp+4096); kf[5]=*(const __attribute__((address_space(3))) bf16x8*)(kp+4608);
  kf[6]=*(const __attribute__((address_space(3))) bf16x8*)(kp+6144); kf[7]=*(const __attribute__((address_space(3))) bf16x8*)(kp+6656);
}
__device__ __forceinline__ void kload2(bf16x8*kf,lds_cptr kp,int j){ kf[2*j]=*(const __attribute__((address_space(3))) bf16x8*)(kp+j*2048); kf[2*j+1]=*(const __attribute__((address_space(3))) bf16x8*)(kp+j*2048+512); }
__device__ __forceinline__ s16x4 vtr(lds_cptr p){ return __builtin_bit_cast(s16x4,__builtin_amdgcn_ds_read_tr16_b64_v4i16((__attribute__((address_space(3))) v4i16_t*)p)); }
__device__ __forceinline__ float rowmax(const f32x16&p0,const f32x16&p1){
  float a=max3f(p0[0],p0[1],p1[0]),b=max3f(p0[2],p0[3],p1[1]);a=max3f(a,p1[2],p1[3]);
  #pragma unroll
  for(int r=4;r<16;r+=4){a=max3f(a,p0[r],p0[r+1]);b=max3f(b,p0[r+2],p0[r+3]);a=max3f(a,p1[r],p1[r+1]);b=max3f(b,p1[r+2],p1[r+3]);}
  const float m=max2f(a,b);
  auto rr=__builtin_amdgcn_permlane32_swap(__float_as_uint(m),__float_as_uint(m),false,false);
  return max2f(__uint_as_float(rr[0]),__uint_as_float(rr[1]));
}
__device__ __forceinline__ void pv(f32x16*o,int vb,bf16x8 pa0,bf16x8 pa1,bf16x8 pa2,bf16x8 pa3){
  #pragma unroll
  for(int d0=0;d0<2;++d0){s16x4 lo[4],hi[4];
    #pragma unroll
    for(int ks=0;ks<4;++ks){
      asm volatile("ds_read_b64_tr_b16 %0,%1 offset:%c2":"=&v"(lo[ks]):"v"(vb),"i"(d0*4096+ks*1024):"memory");
      asm volatile("ds_read_b64_tr_b16 %0,%1 offset:%c2":"=&v"(hi[ks]):"v"(vb),"i"(d0*4096+ks*1024+512):"memory");}
    asm volatile("s_waitcnt lgkmcnt(0)":::"memory");SBAR();
    #define PK(k) (bf16x8){lo[k][0],lo[k][1],lo[k][2],lo[k][3],hi[k][0],hi[k][1],hi[k][2],hi[k][3]}
    o[d0]=__builtin_amdgcn_mfma_f32_32x32x16_bf16(pa0,PK(0),o[d0],0,0,0);
    o[d0]=__builtin_amdgcn_mfma_f32_32x32x16_bf16(pa1,PK(1),o[d0],0,0,0);
    o[d0]=__builtin_amdgcn_mfma_f32_32x32x16_bf16(pa2,PK(2),o[d0],0,0,0);
    o[d0]=__builtin_amdgcn_mfma_f32_32x32x16_bf16(pa3,PK(3),o[d0],0,0,0);
    #undef PK
  }
}

#ifndef ATTN_STORE16
#define ATTN_STORE16(p,v) (*(u32x4*)(p)=(v))
#endif
template<int THRL> __device__ __forceinline__ void attn_unit(const bf16*Qw0,const bf16*__restrict__ Kcol,int latrow0,int nlat,int ctxrow0,int NT,bf16*Ow0,char*shm,const int tid){
  const int lane=tid&63,r32=lane&31,hi=lane>>5; const int wid=__builtin_amdgcn_readfirstlane(tid>>6);
  const bf16*Qw=Qw0+(long)(wid*QBLK)*QP;
  const unsigned lds0=(unsigned)(uintptr_t)shm;
  float*wsf=(float*)(shm+LDS_WS)+wid*64;
  const bf16*ksrc=Kcol+(long)lane*QP+wid*8;
  const bf16*vsrc=Kcol+256+(long)(16*(wid&3)+(lane>>2))*QP+(wid>>2)*32+(lane&3)*8;
  #define TROW(t) ((long)(((t)<nlat)?latrow0+64*(t):ctxrow0+64*((t)-nlat))*QP)
  const unsigned kdst=lds0+LDS_K+wid*1024, vdst=lds0+LDS_V+wid*1024;
  #define DMA_K(t,slot) glds16(ksrc+TROW(t),(unsigned)__builtin_amdgcn_readfirstlane(kdst+(slot)))
  #define DMA_V(t,slot) glds16(vsrc+TROW(t),(unsigned)__builtin_amdgcn_readfirstlane(vdst+(slot)))
  const int vb0=(int)(lds0+LDS_V)+((lane>>4)&1)*32+(lane&3)*8+(4*hi+((lane&15)>>2))*64;
  const char*Kbase=shm+LDS_K; bf16x8 kf[8];
  const lds_cptr shm3=(lds_cptr)shm; const lds_cptr kp0=shm3+LDS_K+hi*1024+r32*16; const lds_cptr vp0=shm3+LDS_V+((lane>>4)&1)*32+(lane&3)*8+(4*hi+((lane&15)>>2))*64;
  DMA_K(0,0);DMA_V(0,0);DMA_K(1,SLOTB);
  bf16x8 qr[4];
  #pragma unroll
  for(int d0=0;d0<4;++d0)qr[d0]=*reinterpret_cast<const bf16x8*>(&Qw[(long)r32*QP+d0*16+hi*8]);
  float mhat=0.f,l_reg=0.f;f32x16 o[2];o[0]=f32x16{};o[1]=f32x16{};const f32x16 negm=f32x16{};
  #define CMASK(P0,P1,t) do{}while(0)
  bool resc=false;
  #define START(P0,P1) do{ const float rm=rowmax(P0,P1); resc=false; \
    { const float dl=rm; mhat=fadd_s(mhat,dl); \
      _Pragma("unroll") for(int r=0;r<16;++r){P0[r]=fsub_s(P0[r],dl);P1[r]=fsub_s(P1[r],dl);} } \
    _Pragma("unroll") for(int r=0;r<16;++r)P0[r]=__builtin_amdgcn_exp2f(P0[r]); }while(0)
  #define RESC() do{ if(resc){ asm volatile("s_waitcnt lgkmcnt(0)":::"memory"); \
      _Pragma("unroll") for(int d_=0;d_<2;++d_) _Pragma("unroll") for(int r=0;r<16;++r)o[d_][r]*=wsf[crow(r,hi)]; } }while(0)
  f32x16 pA0,pA1,pB0,pB1;
  int sl_prev=0,sl_cur=0,sl_next=SLOTB;
  #define ROT() do{sl_prev=sl_cur;sl_cur=sl_next;sl_next=(sl_next==(NSLOT-1)*SLOTB)?0:sl_next+SLOTB;}while(0)
  DMA_K(2,2*SLOTB);
  WAIT_BAR(3);
  qkt(pA0,pA1,Kbase,qr,negm,r32,hi);asm volatile("s_nop 15\n\ts_nop 7":"+v"(pA0),"+v"(pA1));CMASK(pA0,pA1,0);
  START(pA0,pA1);
  _Pragma("unroll") for(int r=0;r<16;++r)pA1[r]=__builtin_amdgcn_exp2f(pA1[r]);
  WAIT_BAR(0);
  DMA_K(3,0);DMA_V(1,SLOTB);
  ROT();
  kload8(kf,kp0+sl_cur);
  WAIT_BAR(2);
  s16x4 vlo[8],vhi[8]; u32x4 pw0,pw1,pw2,pw3;
  #define PKW(P,B) cvtpk_s(P[B],P[B+1])
  #define PAF(k) __builtin_bit_cast(bf16x8,pw##k)
  #define VFR(i) (bf16x8){vlo[i][0],vlo[i][1],vlo[i][2],vlo[i][3],vhi[i][0],vhi[i][1],vhi[i][2],vhi[i][3]}
  #define PIN(x) asm volatile("":"+v"(x))
  #define MX3(a,b,c) __builtin_fmaxf(__builtin_fmaxf((a),(b)),(c))
  #define GAPA(MF,A0,A1,A2,A3,W0,W1,PW) do{ MF; sacc+=A0; sacc+=A1; sacc+=A2; sacc+=A3; PIN(sacc); W0; W1; PIN(PW); SBAR(); }while(0)
  #define EX(v) __builtin_amdgcn_exp2f(v)
  #define GAPB(MF,X,B) do{ MF; X[B]=EX(X[B]); X[B+1]=EX(X[B+1]); X[B+2]=EX(X[B+2]); X[B+3]=EX(X[B+3]); PIN(X); SBAR(); }while(0)
  #define VRD(i) do{ vlo[i]=vtr(vp_+(((i)>>2)*4096+((i)&3)*1024)); vhi[i]=vtr(vp_+(((i)>>2)*4096+((i)&3)*1024+512)); }while(0)
  #define KRD(G,j) do{ if(G){ kload2(kf,kp0+sl_next,j); SBAR(); } }while(0)
  #define STEP(C0,C1,P0,P1,t,GK,GV,GL) do{ SBAR(); \
    const lds_cptr vp_=vp0+sl_prev; \
    VRD(0); SBAR(); float sacc=(P0[0]+P0[1]); \
    GAPA(C0=__builtin_amdgcn_mfma_f32_32x32x16_bf16(kf[0],qr[0],negm,0,0,0), P0[2],P0[3],P0[4],P0[5],     pw0[0]=PKW(P0,0), pw0[1]=PKW(P0,2), pw0); \
    VRD(4); SBAR(); GAPA(C1=__builtin_amdgcn_mfma_f32_32x32x16_bf16(kf[1],qr[0],negm,0,0,0), P0[6],P0[7],P0[8],P0[9],     pw0[2]=PKW(P0,4), pw0[3]=PKW(P0,6), pw0); \
    VRD(1); SBAR(); GAPA(C0=__builtin_amdgcn_mfma_f32_32x32x16_bf16(kf[2],qr[1],C0,0,0,0),   P0[10],P0[11],P0[12],P0[13], pw1[0]=PKW(P0,8), pw1[1]=PKW(P0,10), pw1); \
    VRD(5); SBAR(); GAPA(C1=__builtin_amdgcn_mfma_f32_32x32x16_bf16(kf[3],qr[1],C1,0,0,0),   P0[14],P0[15],P1[0],P1[1],   pw1[2]=PKW(P0,12),pw1[3]=PKW(P0,14), pw1); \
    VRD(2); SBAR(); GAPA(C0=__builtin_amdgcn_mfma_f32_32x32x16_bf16(kf[4],qr[2],C0,0,0,0),   P1[2],P1[3],P1[4],P1[5],     pw2[0]=PKW(P1,0), pw2[1]=PKW(P1,2), pw2); \
    VRD(6); SBAR(); GAPA(C1=__builtin_amdgcn_mfma_f32_32x32x16_bf16(kf[5],qr[2],C1,0,0,0),   P1[6],P1[7],P1[8],P1[9],     pw2[2]=PKW(P1,4), pw2[3]=PKW(P1,6), pw2); \
    VRD(3); SBAR(); GAPA(C0=__builtin_amdgcn_mfma_f32_32x32x16_bf16(kf[6],qr[3],C0,0,0,0),   P1[10],P1[11],P1[12],P1[13], pw3[0]=PKW(P1,8), pw3[1]=PKW(P1,10), pw3); \
    VRD(7); SBAR(); GAPA(C1=__builtin_amdgcn_mfma_f32_32x32x16_bf16(kf[7],qr[3],C1,0,0,0),   P1[14],P1[15],0.f,0.f,       pw3[2]=PKW(P1,12),pw3[3]=PKW(P1,14), pw3); \
    l_reg+=sacc; \
    if(GK){DMA_K((t)+3,sl_cur);} if(GV){DMA_V((t)+1,sl_next);} \
    _Pragma("unroll") for(int r=0;r<16;++r){C0[r]-=mhat;C1[r]-=mhat;} \
    { float a=MX3(C0[0],C0[1],C1[0]),b=MX3(C0[2],C0[3],C1[1]); a=MX3(a,C1[2],C1[3]); \
      _Pragma("unroll") for(int r=4;r<16;r+=4){a=MX3(a,C0[r],C0[r+1]);b=MX3(b,C0[r+2],C0[r+3]);a=MX3(a,C1[r],C1[r+1]);b=MX3(b,C1[r+2],C1[r+3]);} \
      float rm=__builtin_fmaxf(a,b); { auto rr=__builtin_amdgcn_permlane32_swap(__float_as_uint(rm),__float_as_uint(rm),false,false); rm=__builtin_fmaxf(__uint_as_float(rr[0]),__uint_as_float(rr[1])); } \
      resc=false; \
      if(__builtin_expect(__any(rm>(float)THRL),0)){ const float dl=__builtin_fmaxf(rm,0.f); mhat+=dl; \
        _Pragma("unroll") for(int r=0;r<16;++r){C0[r]-=dl;C1[r]-=dl;} \
        const float f=__builtin_amdgcn_exp2f(-dl); l_reg*=f; if(hi==0)wsf[r32]=f; resc=true; } } \
    SBAR(); \
    GAPB(o[0]=__builtin_amdgcn_mfma_f32_32x32x16_bf16(PAF(0),VFR(0),o[0],0,0,0), C0,0); \
    GAPB(o[1]=__builtin_amdgcn_mfma_f32_32x32x16_bf16(PAF(0),VFR(4),o[1],0,0,0), C0,4); \
    KRD(GL,0); GAPB(o[0]=__builtin_amdgcn_mfma_f32_32x32x16_bf16(PAF(1),VFR(1),o[0],0,0,0), C0,8); \
    KRD(GL,1); GAPB(o[1]=__builtin_amdgcn_mfma_f32_32x32x16_bf16(PAF(1),VFR(5),o[1],0,0,0), C0,12); \
    KRD(GL,2); GAPB(o[0]=__builtin_amdgcn_mfma_f32_32x32x16_bf16(PAF(2),VFR(2),o[0],0,0,0), C1,0); \
    KRD(GL,3); GAPB(o[1]=__builtin_amdgcn_mfma_f32_32x32x16_bf16(PAF(2),VFR(6),o[1],0,0,0), C1,4); \
    GAPB(o[0]=__builtin_amdgcn_mfma_f32_32x32x16_bf16(PAF(3),VFR(3),o[0],0,0,0), C1,8); \
    GAPB(o[1]=__builtin_amdgcn_mfma_f32_32x32x16_bf16(PAF(3),VFR(7),o[1],0,0,0), C1,12); \
    }while(0)
  int t=1;
  for(;t+5<NT;t+=2){
    STEP(pB0,pB1,pA0,pA1,t,true,true,true);     WAIT_BAR(2); RESC(); ROT();
    STEP(pA0,pA1,pB0,pB1,t+1,true,true,true);   WAIT_BAR(2); RESC(); ROT();
  }
  #define ENDW(tt) do{ if((tt)+3<NT){WAIT_BAR(2);} else if((tt)+2<NT){WAIT_BAR(1);} else {WAIT_BAR(0);} }while(0)
  for(;t+1<NT;t+=2){
    STEP(pB0,pB1,pA0,pA1,t,(t+3<NT),(t+1<NT),(t+1<NT));       ENDW(t);   RESC(); ROT();
    STEP(pA0,pA1,pB0,pB1,t+1,(t+4<NT),(t+2<NT),(t+2<NT));     ENDW(t+1); RESC(); ROT();
  }
  STEP(pB0,pB1,pA0,pA1,NT-1,false,false,false); RESC();
  { float sacc=pB0[0]+pB0[1]; _Pragma("unroll") for(int r=2;r<16;++r)sacc+=pB0[r]; _Pragma("unroll") for(int r=0;r<16;++r)sacc+=pB1[r]; l_reg+=sacc;
    pw0=(u32x4){PKW(pB0,0),PKW(pB0,2),PKW(pB0,4),PKW(pB0,6)};pw1=(u32x4){PKW(pB0,8),PKW(pB0,10),PKW(pB0,12),PKW(pB0,14)};pw2=(u32x4){PKW(pB1,0),PKW(pB1,2),PKW(pB1,4),PKW(pB1,6)};pw3=(u32x4){PKW(pB1,8),PKW(pB1,10),PKW(pB1,12),PKW(pB1,14)};
    SBAR(); pv(o,vb0+sl_cur,PAF(0),PAF(1),PAF(2),PAF(3)); }
  #undef PKW
  #undef PAF
  #undef VFR
  #undef PIN
  #undef MX3
  #undef GAPA
  #undef GAPB
  #undef EX
  #undef VRD
  #undef KRD
  #undef STEP
  #undef ENDW
  {auto rr=__builtin_amdgcn_permlane32_swap(__float_as_uint(l_reg),__float_as_uint(l_reg),false,false);l_reg=__uint_as_float(rr[0])+__uint_as_float(rr[1]);}
  if(hi==0)wsf[32+r32]=l_reg;asm volatile("s_waitcnt lgkmcnt(0)":::"memory");
  float rli[16];
  #pragma unroll
  for(int r=0;r<16;++r)rli[r]=__builtin_amdgcn_rcpf(wsf[32+crow(r,hi)]);
  bf16*Ow=Ow0+(long)(wid*QBLK)*OP;
  { bf16*stg=(bf16*)(shm+LDS_OST)+wid*2048;
    #pragma unroll
    for(int r=0;r<16;++r){const int orow=crow(r,hi);
      #pragma unroll
      for(int d0=0;d0<2;++d0)stg[orow*64+d0*32+r32]=__float2bfloat16(o[d0][r]*rli[r]);}
    asm volatile("s_waitcnt lgkmcnt(0)":::"memory");
    #pragma unroll
    for(int i=0;i<4;++i){const int row=i*8+(lane>>3),ch=lane&7; const u32x4 v=*(const u32x4*)(stg+row*64+ch*8); ATTN_STORE16(Ow+(long)row*OP+ch*8,v);} }
  asm volatile("s_waitcnt lgkmcnt(0)\n\ts_barrier":::"memory");
  #undef DMA_K
  #undef TROW
  #undef DMA_V
  #undef CMASK
  #undef START
  #undef RESC
  #undef ROT
}
constexpr int ATTN_LDS_BYTES=LDS_BYTES;
#undef SBAR
#undef WAIT_BAR
}
__device__ __forceinline__ void attn_unit_simple(ldsp lds, const bf16_t* QKV, bf16_t* O, int qrow0, int h, int latbase, int nlat_tiles, int ctxbase, int NT, const int tid) {
    const int lane = tid & 63, wid = __builtin_amdgcn_readfirstlane(tid >> 6), l15 = lane & 15, lg = lane >> 4;
    const int kvh = h >> 2;
    const ldsp Kb = lds, Vb = lds + 18432, Pw = lds + 36864 + wid * 4608;
    bf16x8 qf[2][2];
#pragma unroll
    for (int qb = 0; qb < 2; ++qb)
#pragma unroll
        for (int ks = 0; ks < 2; ++ks) qf[qb][ks] = *(const bf16x8*)(QKV + (size_t)(qrow0 + 32 * wid + 16 * qb + l15) * 1536 + h * 64 + 32 * ks + 8 * lg);
    const int lrow = tid >> 3, lch = tid & 7;
    u32x4 kr, vr;
    { const int r = ((0 < nlat_tiles) ? latbase : ctxbase) + lrow; const bf16_t* p = QKV + (size_t)r * 1536 + 1024 + kvh * 64 + lch * 8; kr = *(const u32x4*)p; vr = *(const u32x4*)(p + 256); }
    *(LAS u32x4*)(Kb + lrow * 144 + lch * 16) = kr; *(LAS u32x4*)(Vb + lrow * 144 + lch * 16) = vr;
    __syncthreads();
    f32x4 o[4][2];
#pragma unroll
    for (int db = 0; db < 4; ++db) { o[db][0] = (f32x4){0.f, 0.f, 0.f, 0.f}; o[db][1] = o[db][0]; }
    float mrun[2] = {-INFINITY, -INFINITY}, lsum[2] = {0.f, 0.f};
    for (int t = 0; t < NT; ++t) {
        const int cur = t & 1;
        if (t + 1 < NT) { const int tn = t + 1; const int r = ((tn < nlat_tiles) ? latbase + 64 * tn : ctxbase + 64 * (tn - nlat_tiles)) + lrow;
            const bf16_t* p = QKV + (size_t)r * 1536 + 1024 + kvh * 64 + lch * 8; kr = *(const u32x4*)p; vr = *(const u32x4*)(p + 256); }
        f32x4 s[4][2];
#pragma unroll
        for (int kb = 0; kb < 4; ++kb) {
            const ldsp kp = Kb + cur * 9216 + (16 * kb + l15) * 144 + lg * 16;
            const bf16x8 k0 = *(const LAS bf16x8*)kp, k1 = *(const LAS bf16x8*)(kp + 64);
#pragma unroll
            for (int qb = 0; qb < 2; ++qb) { s[kb][qb] = mfma16(k0, qf[qb][0], (f32x4){0.f, 0.f, 0.f, 0.f}); s[kb][qb] = mfma16(k1, qf[qb][1], s[kb][qb]); }
        }
#pragma unroll
        for (int qb = 0; qb < 2; ++qb) {
            float mx = s[0][qb][0];
#pragma unroll
            for (int kb = 0; kb < 4; ++kb)
#pragma unroll
                for (int j = 0; j < 4; ++j) mx = fmaxf(mx, s[kb][qb][j]);
            mx = fmaxf(mx, __shfl_xor(mx, 16)); mx = fmaxf(mx, __shfl_xor(mx, 32));
            const float mn = fmaxf(mrun[qb], mx), al = __builtin_amdgcn_exp2f(mrun[qb] - mn); mrun[qb] = mn;
            float ps = 0.f;
#pragma unroll
            for (int kb = 0; kb < 4; ++kb) {
                float p[4];
#pragma unroll
                for (int j = 0; j < 4; ++j) { p[j] = __builtin_amdgcn_exp2f(s[kb][qb][j] - mn); ps += p[j]; }
                u32x2 w; w.x = cvt_pk_bf16(p[0], p[1]); w.y = cvt_pk_bf16(p[2], p[3]);
                *(LAS u32x2*)(Pw + (16 * qb + l15) * 144 + (16 * kb + 4 * lg) * 2) = w;
            }
            lsum[qb] = lsum[qb] * al + ps;
#pragma unroll
            for (int db = 0; db < 4; ++db) o[db][qb] *= al;
        }
#pragma unroll
        for (int ks = 0; ks < 2; ++ks) {
            bf16x8 pf[2];
#pragma unroll
            for (int qb = 0; qb < 2; ++qb) pf[qb] = *(const LAS bf16x8*)(Pw + (16 * qb + l15) * 144 + (32 * ks + 8 * lg) * 2);
#pragma unroll
            for (int db = 0; db < 4; ++db) {
                const ldsp vp = Vb + cur * 9216 + (32 * ks + 8 * lg + (l15 >> 2)) * 144 + (16 * db + 4 * (l15 & 3)) * 2;
                const s16x4 lo = lds_tr(vp), hi = lds_tr(vp + 4 * 144);
                const bf16x8 vf = (bf16x8){lo[0], lo[1], lo[2], lo[3], hi[0], hi[1], hi[2], hi[3]};
#pragma unroll
                for (int qb = 0; qb < 2; ++qb) o[db][qb] = mfma16(vf, pf[qb], o[db][qb]);
            }
        }
        if (t + 1 < NT) { *(LAS u32x4*)(Kb + (cur ^ 1) * 9216 + lrow * 144 + lch * 16) = kr; *(LAS u32x4*)(Vb + (cur ^ 1) * 9216 + lrow * 144 + lch * 16) = vr; }
        __syncthreads();
    }
#pragma unroll
    for (int qb = 0; qb < 2; ++qb) {
        float l = lsum[qb]; l += __shfl_xor(l, 16); l += __shfl_xor(l, 32);
        const float inv = 1.0f / l;
        bf16_t* op = O + (size_t)(qrow0 + 32 * wid + 16 * qb + l15) * D + h * 64 + 4 * lg;
#pragma unroll
        for (int db = 0; db < 4; ++db) { u32x2 w; w.x = cvt_pk_bf16(o[db][qb][0] * inv, o[db][qb][1] * inv); w.y = cvt_pk_bf16(o[db][qb][2] * inv, o[db][qb][3] * inv);
            *(u32x2*)(op + 16 * db) = w; }
    }
}
#ifndef ATT_SIMPLE
#define ATT_SIMPLE 0
#endif
__device__ __forceinline__ void attn_phase(ldsp lds, char* shm, const bf16_t* QKV, bf16_t* O, const int tid, const int bx) {
    const int xcd = bx & 7, slot = bx >> 3;
    typedef attn_body::bf16 abf;
    for (int i = 0; i < 4; ++i) {
        const int bk = 8 * i + xcd, b = bk >> 2, kvh = bk & 3, h = kvh * 4 + (slot >> 3), qb = slot & 7;
#if ATT_SIMPLE
        attn_unit_simple(lds, QKV, O, b * SEQ + qb * 256, h, b * SEQ, 32, ML + b * CL, 36, tid);
#else
        attn_body::attn_unit<8>((const abf*)(QKV + (size_t)(b * SEQ + qb * 256) * 1536 + h * 64), (const abf*)(QKV + 1024 + kvh * 64), b * SEQ, 32, ML + b * CL, 36,
                                (abf*)(O + (size_t)(b * SEQ + qb * 256) * D + h * 64), shm, tid);
#endif
    }
    if (slot < 16) { const int b = xcd, h = slot;
#if ATT_SIMPLE
        attn_unit_simple(lds, QKV, O, ML + b * CL, h, 0, 0, ML + b * CL, 4, tid);
#else
        attn_body::attn_unit<8>((const abf*)(QKV + (size_t)(ML + b * CL) * 1536 + h * 64), (const abf*)(QKV + 1024 + (h >> 2) * 64), 0, 0, ML + b * CL, 4,
                                (abf*)(O + (size_t)(ML + b * CL) * D + h * 64), shm, tid);
#endif
    }
}

__device__ __forceinline__ void ret_unit(ldsp lds, bf16_t* R, const bf16_t* RC, int b, int h, int qblk, float lgf2, float lgb2, const int tid_in) {
    int tl0_ = tid_in; asm volatile("" : "+v"(tl0_));
    const int tid_outer = tl0_;
    const int wid = __builtin_amdgcn_readfirstlane(tid_outer >> 6);
    const ldsp Ks = lds, Vs = lds + 67584, Ps = lds + 134144;
    const int q0 = qblk * 64, rowq0 = b * SEQ + q0;
    const int qb = wid & 3, kbp = wid >> 2;
    bf16x8 qf[8];
    { const int l15 = tid_outer & 15, lg = (tid_outer & 63) >> 4;
#pragma unroll
      for (int ks = 0; ks < 8; ++ks) qf[ks] = *(const bf16x8*)(R + (size_t)(rowq0 + 16 * qb + l15) * 6144 + h * 256 + 32 * ks + 8 * lg); }
    u32x4 vr[8];
#define RET_BAR() do { asm volatile("s_waitcnt lgkmcnt(0)" ::: "memory"); __builtin_amdgcn_s_barrier(); asm volatile("" ::: "memory"); } while (0)
#define RET_KV(t) const char* kb_; unsigned kp_; \
        if ((t) < 32) { kb_ = (const char*)(R + (size_t)(b * SEQ + 64 * (t)) * 6144 + 1024 + h * 256); kp_ = 6144u * 2u; } \
        else { kb_ = (const char*)(RC + (size_t)(b * CL + 64 * ((t) - 32)) * 3072 + h * 256); kp_ = 3072u * 2u; }
#define RET_DMAK(t, buf) do { RET_KV(t) const int hf_ = lane >> 5; \
        _Pragma("unroll") for (int i_ = 0; i_ < 4; ++i_) { const int pp_ = 4 * wid + i_; const int row_ = 16 * (pp_ >> 3) + (pp_ & 7) + 8 * hf_; \
            attn_body::glds16(kb_ + (size_t)row_ * kp_ + (unsigned)(((lane & 31) ^ hf_) * 16), (unsigned)__builtin_amdgcn_readfirstlane((int)(unsigned)(size_t)(Ks + (buf) * 33792 + pp_ * 1056))); } } while (0)
#define RET_LOADV(t) do { RET_KV(t) const char* vb_ = kb_ + (1024 + h * 256) * 2; const unsigned lo_ = (unsigned)(tid >> 6) * kp_ + (unsigned)(tid & 63) * 16u; \
        _Pragma("unroll") for (int i_ = 0; i_ < 8; ++i_) vr[i_] = *(const u32x4*)(vb_ + (size_t)(8u * i_) * kp_ + lo_); } while (0)
#define RET_STOREV() do { _Pragma("unroll") for (int i_ = 0; i_ < 8; ++i_) *(LAS u32x4*)(Vs + ((tid >> 6) + 8 * i_) * 1040 + (tid & 63) * 16) = vr[i_]; } while (0)
#define RET_S(t) do { const ldsp pbuf_ = Ps + ((t) & 1) * 9216; \
        const ldsp krd_ = Ks + ((t) & 1) * 33792 + (l15 & 7) * 1056 + (l15 >> 3) * 512; const int hx_ = l15 >> 3; \
        f32x4 s_[2]; s_[0] = (f32x4){0.f, 0.f, 0.f, 0.f}; s_[1] = s_[0]; \
        _Pragma("unroll") for (int kh = 0; kh < 2; ++kh) { bf16x8 kfb_[8];       \
            _Pragma("unroll") for (int i_ = 0; i_ < 8; ++i_) kfb_[i_] = *(const LAS bf16x8*)(krd_ + (2 * kbp + (i_ & 1)) * 8 * 1056 + (((4 * (4 * kh + (i_ >> 1)) + lg) ^ hx_) * 16)); \
            _Pragma("unroll") for (int i_ = 0; i_ < 8; ++i_) s_[i_ & 1] = mfma16(kfb_[i_], qf[4 * kh + (i_ >> 1)], s_[i_ & 1]); } \
        const int p_ = q0 + 16 * qb + l15; \
        _Pragma("unroll") for (int kk = 0; kk < 2; ++kk) { float pv_[4]; \
            _Pragma("unroll") for (int j = 0; j < 4; ++j) { const int key_ = 16 * (2 * kbp + kk) + 4 * lg + j; float w_; \
                if ((t) < 32) { const int d_ = p_ - (64 * (t) + key_); const float ad_ = (float)(d_ >= 0 ? d_ : -d_); w_ = __builtin_amdgcn_exp2f((d_ >= 0 ? lgf2 : lgb2) * ad_); } \
                else { const int jj_ = 64 * ((t) - 32) + key_; w_ = __builtin_amdgcn_exp2f(lgf2 * (float)(p_ + CL - jj_)) + __builtin_amdgcn_exp2f(lgb2 * (float)(SEQ - p_ + jj_)); } \
                pv_[j] = s_[kk][j] * w_; } \
            u32x2 w2_; w2_.x = cvt_pk_bf16(pv_[0], pv_[1]); w2_.y = cvt_pk_bf16(pv_[2], pv_[3]); \
            *(LAS u32x2*)(pbuf_ + (16 * qb + l15) * 144 + (16 * (2 * kbp + kk) + 4 * lg) * 2) = w2_; } } while (0)
#define RET_PV(t) do { const ldsp pbuf_ = Ps + ((t) & 1) * 9216; \
        _Pragma("unroll") for (int ks = 0; ks < 2; ++ks) { bf16x8 pf_[4]; \
            _Pragma("unroll") for (int q4 = 0; q4 < 4; ++q4) pf_[q4] = *(const LAS bf16x8*)(pbuf_ + (16 * q4 + l15) * 144 + (32 * ks + 8 * lg) * 2); \
            _Pragma("unroll") for (int db = 0; db < 4; ++db) { \
                const ldsp vp_ = Vs + (32 * ks + 8 * lg + (l15 >> 2)) * 1040 + (64 * wid + 16 * db + 4 * (l15 & 3)) * 2; \
                const s16x4 lo_ = lds_tr(vp_), hi_ = lds_tr(vp_ + 4 * 1040); \
                const bf16x8 vf_ = (bf16x8){lo_[0], lo_[1], lo_[2], lo_[3], hi_[0], hi_[1], hi_[2], hi_[3]}; \
                _Pragma("unroll") for (int q4 = 0; q4 < 4; ++q4) o[db][q4] = mfma16(vf_, pf_[q4], o[db][q4]); } } } while (0)
    f32x4 o[4][4];
#pragma unroll
    for (int db = 0; db < 4; ++db)
#pragma unroll
        for (int q4 = 0; q4 < 4; ++q4) o[db][q4] = (f32x4){0.f, 0.f, 0.f, 0.f};
    { const int tid = tid_outer, lane = tid & 63, l15 = lane & 15, lg = lane >> 4;
      RET_BAR();
      RET_DMAK(0, 0); RET_DMAK(1, 1); RET_LOADV(0);
      asm volatile("s_waitcnt vmcnt(0)" ::: "memory");
      RET_STOREV();
      RET_BAR();
      RET_S(0);
      RET_LOADV(1);
      RET_BAR();
      RET_DMAK(2, 0); }
    for (int t = 0; t < 36; ++t) {
        int tl_ = tid_outer; asm volatile("" : "+v"(tl_));
        const int tid = tl_, lane = tid & 63, l15 = lane & 15, lg = lane >> 4;
        if (wid < 4) { RET_PV(t); if (t + 1 < 36) RET_S(t + 1); }
        else { if (t + 1 < 36) RET_S(t + 1); RET_PV(t); }
        RET_BAR();
        asm volatile("s_waitcnt vmcnt(0)" ::: "memory");
        if (t + 1 < 36) RET_STOREV();
        if (t + 2 < 36) RET_LOADV(t + 2);
        if (t + 3 < 36) RET_DMAK(t + 3, (t + 1) & 1);
        RET_BAR();
    }
#undef RET_KV
#undef RET_DMAK
#undef RET_LOADV
#undef RET_STOREV
#undef RET_S
#undef RET_PV
    const int lane = tid_outer & 63, l15 = lane & 15, lg = lane >> 4;
    LAS float* red = (LAS float*)Ps;
#pragma unroll
    for (int q4 = 0; q4 < 4; ++q4) {
        float ss = 0.f;
#pragma unroll
        for (int db = 0; db < 4; ++db)
#pragma unroll
            for (int j = 0; j < 4; ++j) ss += o[db][q4][j] * o[db][q4][j];
        ss += __shfl_xor(ss, 16); ss += __shfl_xor(ss, 32);
        if (lg == 0) red[wid * 64 + 16 * q4 + l15] = ss;
    }
    RET_BAR();
#pragma unroll
    for (int q4 = 0; q4 < 4; ++q4) {
        float tot = 0.f;
#pragma unroll
        for (int w = 0; w < 8; ++w) tot += red[w * 64 + 16 * q4 + l15];
        const float rstd = 1.0f / sqrtf(tot * (1.f / 512.f) + EPS);
        bf16_t* gp = R + (size_t)(rowq0 + 16 * q4 + l15) * 6144 + 4096 + h * 512 + 64 * wid + 4 * lg;
#pragma unroll
        for (int db = 0; db < 4; ++db) { const u32x2 g2 = *(const u32x2*)(gp + 16 * db);
            u32x2 w; w.x = cvt_pk_bf16(o[db][q4][0] * rstd * silu_f(bflo(g2.x)), o[db][q4][1] * rstd * silu_f(bfhi(g2.x)));
            w.y = cvt_pk_bf16(o[db][q4][2] * rstd * silu_f(bflo(g2.y)), o[db][q4][3] * rstd * silu_f(bfhi(g2.y)));
            *(u32x2*)(gp + 16 * db) = w; }
    }
    RET_BAR();
#undef RET_BAR
}
__device__ __forceinline__ void ret_phase(ldsp lds, bf16_t* R, const bf16_t* RC, const float* decay, const int tid, const int bx) {
    const int xcd = bx & 7, slot = bx >> 3;
    for (int i = 0; i < 4; ++i) {
        const int bh = 8 * i + xcd, b = bh >> 2, h = bh & 3;
        const float lgf2 = decay[h], lgb2 = decay[4 + h];
        ret_unit(lds, R, RC, b, h, slot, lgf2, lgb2, tid);
    }
}

#define XB_TMO      128
#define XB_XCNT(j)  (256  + 64 * (j))
#define XB_XSUB(j)  (1280 + 64 * (j))
#define XB_XGEN(j)  (2304 + 64 * (j))
#define XB_TOP      3328
#define XB_TOPGEN   3392
#define XB_SPIN_CAP (1u << 22)
__device__ __forceinline__ unsigned xb_ld(unsigned* p)              { return __hip_atomic_load(p, __ATOMIC_RELAXED, __HIP_MEMORY_SCOPE_AGENT); }
__device__ __forceinline__ unsigned xb_add(unsigned* p, unsigned v) { return __hip_atomic_fetch_add(p, v, __ATOMIC_RELAXED, __HIP_MEMORY_SCOPE_AGENT); }
__device__ __forceinline__ unsigned xb_xcc_id() { return (unsigned)__builtin_amdgcn_s_getreg((3 << 11) | 20) & 0xFu; }
#define XB_SPIN(cond, bar) do { unsigned _sp = 0; while (cond) { __builtin_amdgcn_s_sleep(1); \
    if ((++_sp & 255u) == 0u) { if (xb_ld(&(bar)[XB_TMO])) break; if (_sp > XB_SPIN_CAP) { atomicAdd(&(bar)[XB_TMO], 1u); break; } } } } while (0)
__device__ __forceinline__ void xcd_barrier_complete(unsigned* bar, unsigned x, unsigned& nloc, unsigned& nx) {
    const unsigned G = gridDim.x * gridDim.y * gridDim.z;
    unsigned sum, cnt, mine, sp = 0u;
    for (;;) {
        sum = 0u; cnt = 0u; mine = 0u;
#pragma unroll
        for (unsigned j = 0; j < 16; ++j) { const unsigned c = xb_ld(&bar[XB_XCNT(j)]); sum += c; cnt += (c > 0u) ? 1u : 0u; mine = (j == x) ? c : mine; }
        if (sum == G) break;
        __builtin_amdgcn_s_sleep(1);
        if ((++sp & 255u) == 0u) { if (xb_ld(&bar[XB_TMO])) break; if (sp > XB_SPIN_CAP) { atomicAdd(&bar[XB_TMO], 1u); break; } }
    }
    nloc = mine > 0u ? mine : 1u; nx = cnt > 0u ? cnt : 1u;
}
__device__ __forceinline__ void xcd_barrier(unsigned* bar, volatile LAS unsigned* st, const int tid) {
    asm volatile("s_waitcnt vmcnt(0)" ::: "memory");
    __syncthreads();
    if (tid == 0) {
        const unsigned x = xb_xcc_id();
        __builtin_amdgcn_s_waitcnt(0);
        unsigned nloc = st[0], nx = st[1];
        if (nloc == 0u) { xcd_barrier_complete(bar, x, nloc, nx); st[0] = nloc; st[1] = nx; }
        const unsigned old = xb_add(&bar[XB_XSUB(x)], 1u);
        const unsigned gen = old / nloc;
        if (old + 1u == (gen + 1u) * nloc) {
            __builtin_amdgcn_fence(__ATOMIC_RELEASE, "agent");
            asm volatile("s_waitcnt vmcnt(0)" ::: "memory");
            const unsigned og = xb_add(&bar[XB_TOP], 1u);
            const unsigned tg = og / nx;
            if (og + 1u == (tg + 1u) * nx) xb_add(&bar[XB_TOPGEN], 1u);
            else XB_SPIN(xb_ld(&bar[XB_TOPGEN]) == tg, bar);
            __builtin_amdgcn_fence(__ATOMIC_ACQUIRE, "agent");
            xb_add(&bar[XB_XGEN(x)], 1u);
            asm volatile("s_waitcnt vmcnt(0)" ::: "memory");
        } else {
            XB_SPIN(xb_ld(&bar[XB_XGEN(x)]) == gen, bar);
            __builtin_amdgcn_fence(__ATOMIC_ACQUIRE, "agent");
            asm volatile("s_waitcnt vmcnt(0)" ::: "memory");
        }
    }
    __syncthreads();
}

constexpr int N_PHASES = 42;
__global__ void __launch_bounds__(512, 2) fwd_megakernel(Args a_in) {
    extern __shared__ __attribute__((aligned(16))) unsigned char lds_raw[];
    const ldsp lds = (ldsp)lds_raw;
    cg::grid_group grid = cg::this_grid();
    { volatile LAS unsigned* st0 = (volatile LAS unsigned*)(lds + MISC_OFF);
      if (threadIdx.x < 16) st0[threadIdx.x] = 0u;
      __syncthreads();
      if (threadIdx.x == 0 && a_in.coop) (void)xb_add(&((unsigned*)(a_in.ws + WS_CTL))[XB_XCNT(xb_xcc_id())], 1u); }
    bool need_sync = false; int zz = 0;
    const int ph_lo = a_in.ph_lo, ph_hi = a_in.ph_hi, coop = a_in.coop;
    for (int ph = ph_lo; ph < ph_hi; ++ph) {
        const __attribute__((address_space(4))) Args* apz = (const __attribute__((address_space(4))) Args*)__builtin_amdgcn_kernarg_segment_ptr();
        asm volatile("" : "+s"(apz));
        const __attribute__((address_space(4))) Args& a = *apz;
        int tid = threadIdx.x; asm volatile("" : "+v"(tid));
        const int wave = __builtin_amdgcn_readfirstlane(tid >> 6);
#define LANE_ ({ int t__ = tid; asm volatile("" : "+v"(t__)); t__ & 63; })
        int bid = blockIdx.x; asm volatile("" : "+s"(bid));
        const int G = gridDim.x, gw = bid * 8 + wave, NGW = G * 8, gtid = bid * 512 + tid, NTH = G * 512;
        unsigned char* ws = a.ws;
        float* mods = (float*)(ws + WS_MODS);
        float* XC = (float*)(ws + WS_XC);
        bf16_t* H = (bf16_t*)(ws + WS_H);
        bf16_t* U = (bf16_t*)(ws + WS_U);
        bf16_t* RC = (bf16_t*)(ws + WS_RC);
        bf16_t* SIDE = (bf16_t*)(ws + WS_SIDE);
        int kind = -1, layer = 0, slot = 0;
        if (ph == 0) kind = 0; else if (ph == 41) kind = 8;
        else { layer = (ph - 1) / 10; slot = (ph - 1) % 10;
            kind = (slot == 0 || slot == 5) ? 1 : (slot == 1 || slot == 6) ? 2 : slot == 2 ? 3 : slot == 3 ? 4 : (slot == 4 || slot == 9) ? 5 : slot == 7 ? 6 : 7; }
        const int mixer = layer % 3;
        if (kind == 4 && mixer == 0) continue;
        if (kind == 6) continue;
        if (kind == 3 && mixer != 0) continue;
        const bool fusedn = (G == 256);
        const int rows_full = (layer < 2) ? MT : ML;
        const int nrows = (kind == 1) ? ((slot == 0 && layer == 2) ? MT : rows_full) : 0;
        const int nrow0 = (kind == 1 && fusedn && ph > 1) ? ML : 0;
        if (kind == 1 && nrows <= nrow0) continue;
        if (kind == 8 && fusedn) continue;
        const int zr = (kind == 5) ? PROBE_GR : (kind == 7) ? PROBE_GB : 1;
        const bool dummy = zz + 1 < zr;
        if (need_sync && coop) { for (int z = 0; z <= PROBE_SYNC; ++z) { if (a.pad == 0x5eed) grid.sync(); else xcd_barrier((unsigned*)(ws + WS_CTL), (volatile LAS unsigned*)(lds + MISC_OFF), tid); } }
        need_sync = true;
        const float* modl = mods + (size_t)layer * 9 * NMOD;
        const float* xs_lat = (layer == 0 && slot <= 4) ? a.x : a.out;
        const float* xs_ctx = XC;
        if (kind == 0) {
#ifndef NO_PRO
 for (int z = 0; z < PROBE_PRO; ++z) prologue(a, lds, gw, NGW, wave, LANE_, tid, bid, G);
#endif
 }
        else if (kind == 1) {
            const bool mix = slot == 0; const int rows = nrows;
            const bool haspart = (ph > 1) && (ph <= 21);
            norm_phase(xs_lat, xs_ctx, haspart ? (const float*)(ws + WS_PARTA) : nullptr, (const float*)(ws + WS_PARTB), XC, nrow0, rows, (mix ? a.norm_mix_g : a.norm_ffn_g) + layer * D, modl, mix ? 0 : 3072, mix ? 1024 : 4096, H, gw, NGW, LANE_);
        } else if (kind == 2) {
            const bool retl = (slot == 1 && mixer == 2);
            if (retl) {
                pg8::Gemm g{H, (const bf16_t*)(ws + WS_RIN), ML, 2048, D, D, D}; pg8::EpiRope ER{U, 6144, 4};
                pg8::StaticOrder S; S.init(g.M, g.N, G, bid);
                pg8::gemm_phase<pg8::EpiRope>(lds, g, S, ER, tid);
            }
            if (slot == 1 && mixer == 1) {
                pg8::Gemm g{H, (const bf16_t*)(ws + WS_AQKV), MT, 1536, D, D, D}; pg8::EpiQKV EQ{U, a.attn_qg, a.attn_kg};
                pg8::StaticOrder S; S.init(g.M, g.N, G, bid);
                pg8::gemm_phase<pg8::EpiQKV>(lds, g, S, EQ, tid);
            }
            if (slot == 6) {
                pg8::Gemm g{H, (const bf16_t*)(ws + WS_UP) + (size_t)layer * DFF2 * D, rows_full, DFF2, D, D, D};
                pg8::EpiGate EG{U, SIDE, a.ffn_conv_k + (size_t)layer * 3 * DFF2, a.ffn_conv_b + (size_t)layer * DFF2};
                pg8::StaticOrder S; S.init(g.M, g.N, G, bid);
                pg8::gemm_phase<pg8::EpiGate>(lds, g, S, EG, tid);
            }
            const int nrep = retl ? 2 : ((slot == 1 && mixer == 1) || slot == 6) ? 0 : 1;
            for (int rep0 = 0; rep0 < nrep * PROBE_GS; ++rep0) { const int rep = rep0 % nrep;
                pg8::Gemm g; pg8::EpiStore E;
                if (mixer == 0) { g = pg8::Gemm{H, (const bf16_t*)(ws + WS_CIN) + (size_t)(layer / 3) * 3072 * D, rows_full, 3072, D, D, D}; E = pg8::EpiStore{U, 3072, nullptr, 0, 1.0f}; }
                else if (rep == 0) { g = pg8::Gemm{H, (const bf16_t*)(ws + WS_RIN) + (size_t)2048 * D, ML, 4096, D, D, D}; E = pg8::EpiStore{U + 2048, 6144, nullptr, 0, 1.0f}; }
                else { g = pg8::Gemm{H + (size_t)ML * D, (const bf16_t*)(ws + WS_RIN) + (size_t)1024 * D, MC, 3072, D, D, D}; E = pg8::EpiStore{RC, 3072, nullptr, 4, 0.0625f}; }
                pg8::StaticOrder S; S.init(g.M, g.N, G, bid);
#ifndef NO_GS
                pg8::gemm_phase<pg8::EpiStore>(lds, g, S, E, tid);
#endif
            }
            { const int cset = (ph == 2) ? 1 : (ph == 7) ? 2 : (ph == 17) ? 3 : 0, c0 = (ph == 2) ? 96 : 48;
              if (cset != 0 && G == 256 && bid >= c0) convert_set(a, lds, cset, (bid - c0) * 8 + wave, (256 - c0) * 8, wave, LANE_); }
        } else if (kind == 3) {
#ifndef NO_PREP
            if (mixer == 0) for (int z = 0; z < PROBE_EW; ++z) convgate_phase(U, H, rows_full, a.conv_k + (size_t)(layer / 3) * 3 * D, gw, NGW, LANE_);
            else if (mixer == 1) attnprep_phase(U, a.attn_qg, a.attn_kg, gw, NGW, LANE_);
            else retprep_phase(U, RC, gw, NGW, LANE_);
#endif
        } else if (kind == 4) {
#ifndef NO_ATT
            if (mixer == 1) for (int z = 0; z < PROBE_ATT; ++z) attn_phase(lds, (char*)lds_raw, U, H, tid, bid);
#endif
#ifndef NO_RET
            if (mixer == 2) ret_phase(lds, U, RC, mods + 4 * 9 * NMOD, tid, bid);
#endif
        } else if (kind == 5) {
            const int nrep = (layer < 2) ? 3 : 1;
            for (int rep = 0; rep < nrep; ++rep) {
                pg8::Gemm g; int goff = 2048;
                if (slot == 9) { g = pg8::Gemm{U, (const bf16_t*)(ws + WS_DN) + (size_t)layer * D * DFF, ML, D, DFF, DFF, DFF}; goff = 5120; }
                else if (mixer == 0) { g = pg8::Gemm{H, (const bf16_t*)(ws + WS_COUT) + (size_t)(layer / 3) * D * D, ML, D, D, D, D}; }
                else if (mixer == 1) { g = pg8::Gemm{H, (const bf16_t*)(ws + WS_AOUT), ML, D, D, D, D}; }
                else { g = pg8::Gemm{U + 4096, (const bf16_t*)(ws + WS_ROUT), ML, D, 2048, 6144, 2048}; }
                int split = 1, cid = bid, kq0 = 0; unsigned kpart = 0u, koff0 = 0u;
                float* part = nullptr;
                if (rep > 0) {
                    g.A += (size_t)ML * g.lda; g.M = MC; split = 2; part = (float*)(ws + (rep == 1 ? WS_PARTA : WS_PARTB));
                    if (slot == 9) { if (rep == 1) { g.K = 768; kpart = 1536u; } else { g.K = 640; kpart = 1280u; koff0 = 3072u; cid = (bid + 192) & 255; } }
                    else { g.K = 256; kpart = 512u; if (rep == 2) { koff0 = 1024u; cid = (bid + 192) & 255; } }
                }
                pg8::StaticOrder S; S.init(g.M, g.N, G, cid, split, kpart, koff0, kq0);
                if (rep == 0 && fusedn) {
                    const bool fin = (slot == 9 && layer == 3); const int nl = (slot == 9) ? layer + 1 : layer;
                    const float* gain = fin ? a.final_g : ((slot == 9) ? a.norm_mix_g : a.norm_ffn_g) + nl * D;
                    const int inst = layer * 2 + (slot == 9 ? 1 : 0);
                    pg8::EpiResidNorm EN{xs_lat, a.out, modl + goff, gain, mods + (size_t)(fin ? 0 : nl) * 9 * NMOD, (slot == 9) ? 0 : 3072, (slot == 9) ? 1024 : 4096,
                                         H, (unsigned*)(ws + WS_XBUF), (unsigned*)(ws + WS_CTL + 16384 + inst * 16384), fin ? 1 : 0};
                    pg8::gemm_phase<pg8::EpiResidNorm>(lds, g, S, EN, tid);
                } else {
                    pg8::EpiResid E{xs_lat, XC, a.out, XC, dummy ? (const float*)(ws + WS_CTL + CTL_ZEROS) : modl + goff, rep ? ML : 0, part};
                    pg8::gemm_phase<pg8::EpiResid>(lds, g, S, E, tid);
                }
            }
        } else if (kind == 6) { for (int z = 0; z < PROBE_EW; ++z) ffngate_a(U, SIDE, rows_full, gtid, NTH); }
        else if (kind == 7) {
#ifndef NO_GB
 ffngate_fix(U, SIDE, rows_full, a.ffn_conv_k + (size_t)layer * 3 * DFF2, a.ffn_conv_b + (size_t)layer * DFF2, gw, NGW, LANE_);
#endif
 }
        else if (kind == 8) { final_phase(a.out, a.final_g, gw, NGW, LANE_); }
        if (dummy) { ++zz; --ph; } else zz = 0;
    }
}

extern "C" void kernel_launch(void* const* d_in, const int* in_sizes, int n_in, void* d_out, int out_size, void* d_ws, size_t ws_size, hipStream_t stream) {
    static int grid = 0;
    if (grid == 0) {
        if (n_in != 23 || out_size != ML * D || ws_size < WS_END) { fprintf(stderr, "kernel_launch: unexpected shapes (n_in %d out %d ws %zu)\n", n_in, out_size, ws_size); grid = -1; return; }
        int dev = 0, cus = 0, per_cu = 0;
        hipGetDevice(&dev);
        hipDeviceGetAttribute(&cus, hipDeviceAttributeMultiprocessorCount, dev);
        hipFuncSetAttribute((const void*)fwd_megakernel, hipFuncAttributeMaxDynamicSharedMemorySize, LDS_BYTES);
        hipOccupancyMaxActiveBlocksPerMultiprocessor(&per_cu, (const void*)fwd_megakernel, 512, LDS_BYTES);
        (void)hipGetLastError();
        if (per_cu < 1) per_cu = 1;
        grid = cus;
        if (grid != 256) fprintf(stderr, "kernel_launch: %d CUs (expected 256)\n", grid);
    }
    if (grid < 0) return;
    if (hipMemsetAsync((char*)d_ws + WS_CTL, 0, CTL_BYTES, stream) != hipSuccess) { fprintf(stderr, "kernel_launch: memset failed\n"); return; }
    Args a{};
    const float** ap = (const float**)&a;
    for (int i = 0; i < 23; ++i) ap[i] = (const float*)d_in[i];
    a.out = (float*)d_out; a.ws = (unsigned char*)d_ws;
#if MK_PER_PHASE
    for (int ph = 0; ph < N_PHASES; ++ph) { a.ph_lo = ph; a.ph_hi = ph + 1; a.coop = 0; hipLaunchKernelGGL(fwd_megakernel, dim3(grid), dim3(512), LDS_BYTES, stream, a); }
#else
    a.ph_lo = 0; a.ph_hi = N_PHASES; a.coop = 1;
    void* args[] = {&a};
    hipError_t e = hipLaunchCooperativeKernel((const void*)fwd_megakernel, dim3(grid), dim3(512), args, LDS_BYTES, stream);
    if (e != hipSuccess) fprintf(stderr, "cooperative launch failed: %s (grid %d)\n", hipGetErrorString(e), grid);
#endif
}
```
